# Optimizing an MI355X kernel written in HIP

```python
import math
import jax
import jax.numpy as jnp
from jax import lax
import numpy as np


D_MODEL = 2048
BATCH = 8
SEQ = 4096
DEPTH = 2

GRID_W = 64
CTX_LEN = 256
D_FF = 5632
N_MOD = 9
N_NORM = 6
MIX_A = D_MODEL // 2
MIX_B = D_MODEL // 2
CONV_W = 3
POOL_WINDOWS = (2, 4, 8, 16)
POOL_GROUPS = len(POOL_WINDOWS)
POOL_CH = MIX_B // POOL_GROUPS
IN_COLS = 3 * MIX_A + MIX_B
S5_GROUP_CH = 16
S5_GROUPS = D_MODEL // S5_GROUP_CH
S5_STATE = 64
DT_MIN = 1e-3
DT_MAX = 1e-1
N_EVEN = (DEPTH + 1) // 2
N_ODD = DEPTH // 2
EPS = 1e-6

kernel_name = 'hybrid_conv_pool_s5_flow_block'


def rmsnorm(x, g):
    xf = x.astype(jnp.float32)
    y = xf * lax.rsqrt(jnp.mean(xf * xf, axis=-1, keepdims=True) + EPS) * g.astype(jnp.float32)
    return y.astype(x.dtype)


def pre(x, m, g, i):
    return rmsnorm(x, g[2 * i]) * (1 + m[3 * i + 1]) + m[3 * i]


def post(x, y, m, g, i, weight):
    return x + weight * m[3 * i + 2] * rmsnorm(y, g[2 * i + 1])


def swiglu(h, wg, wu, wd):
    return (jax.nn.silu(h @ wg) * (h @ wu)) @ wd


def half_ffn(x, m, g, i, wg, wu, wd):
    return post(x, swiglu(pre(x, m, g, i), wg, wu, wd), m, g, i, 0.5)


def shift_conv3(z, w):
    zp = jnp.pad(z, ((0, 0), (1, 1), (0, 0)))
    return w[0] * zp[:, :-2] + w[1] * z + w[2] * zp[:, 2:]


def pool_minus_self(u, w, axis):
    n = u.shape[axis]
    uf = u.astype(jnp.float32)
    pad = [(0, 0)] * u.ndim
    pad[axis] = (1, 0)
    csum = jnp.pad(jnp.cumsum(uf, axis=axis), pad)
    j = np.arange(n)
    lo = np.clip(j - w // 2, 0, n)
    hi = np.clip(j + w // 2, 0, n)
    total = jnp.take(csum, hi, axis=axis) - jnp.take(csum, lo, axis=axis)
    cnt_shape = [1] * u.ndim
    cnt_shape[axis] = n
    cnt = jnp.asarray((hi - lo).astype(np.float32).reshape(cnt_shape))
    return (total / cnt - uf).astype(u.dtype)


def multiscale_pool(u, grid):
    b, n, _ = u.shape
    ug = u.reshape(b, n, POOL_GROUPS, POOL_CH)
    outs = []
    for gi, w in enumerate(POOL_WINDOWS):
        ui = ug[:, :, gi]
        if grid:
            rows = n // GRID_W
            pi = pool_minus_self(ui.reshape(b, rows, GRID_W, POOL_CH), w, axis=2).reshape(b, n, POOL_CH)
        else:
            pi = pool_minus_self(ui, w, axis=1)
        outs.append(pi)
    return jnp.stack(outs, axis=2)


def even_mixer(h, w_in, conv_w, pool_w, pool_scale, w_out, grid):
    p = h @ w_in
    gate_b, gate_c, v, u = jnp.split(p, [MIX_A, 2 * MIX_A, 3 * MIX_A], axis=-1)
    y_a = gate_b * shift_conv3(gate_c * v, conv_w)
    pooled = multiscale_pool(u, grid)
    y_b = jnp.einsum('blgc,gcd->blgd', pooled, pool_w).reshape(u.shape) * pool_scale
    return jnp.concatenate([y_a, y_b], axis=-1) @ w_out


def complex_mul(ar, ai, br, bi):
    return ar * br - ai * bi, ar * bi + ai * br


def s5_discretise(lam_re, lam_im, log_step, b_re, b_im):
    lam_re = lam_re.astype(jnp.float32)
    lam_im = lam_im.astype(jnp.float32)
    dt = jnp.exp(log_step.astype(jnp.float32))[..., None]
    mag = jnp.exp(lam_re * dt)
    lbar_re = mag * jnp.cos(lam_im * dt)
    lbar_im = mag * jnp.sin(lam_im * dt)
    den = lam_re * lam_re + lam_im * lam_im
    nr = lbar_re - 1.0
    fr = (nr * lam_re + lbar_im * lam_im) / den
    fi = (lbar_im * lam_re - nr * lam_im) / den
    bbar_re, bbar_im = complex_mul(fr[..., None], fi[..., None], b_re.astype(jnp.float32), b_im.astype(jnp.float32))
    return lbar_re, lbar_im, bbar_re, bbar_im


def scan_combine(e1, e2):
    a1r, a1i, b1r, b1i = e1
    a2r, a2i, b2r, b2i = e2
    ar, ai = complex_mul(a1r, a1i, a2r, a2i)
    br, bi = complex_mul(a2r, a2i, b1r, b1i)
    return ar, ai, br + b2r, bi + b2i


def diag_scan(lbar_re, lbar_im, bu_re, bu_im, reverse, s0=None):
    if s0 is not None:
        idx = -1 if reverse else 0
        inj_re, inj_im = complex_mul(lbar_re, lbar_im, s0[0], s0[1])
        bu_re = bu_re.at[idx].add(inj_re)
        bu_im = bu_im.at[idx].add(inj_im)
    a_re = jnp.broadcast_to(lbar_re, bu_re.shape)
    a_im = jnp.broadcast_to(lbar_im, bu_im.shape)
    _, _, s_re, s_im = lax.associative_scan(scan_combine, (a_re, a_im, bu_re, bu_im), reverse=reverse, axis=0)
    return s_re, s_im


def s5_mixer(h_lat, h_ctx, lam_re, lam_im, log_step, b_re, b_im, c_re, c_im, d_skip, w_a, w_b, ctx_out):
    lbr, lbi, bbr, bbi = s5_discretise(lam_re, lam_im, log_step, b_re, b_im)
    cr = c_re.astype(jnp.float32)
    ci = c_im.astype(jnp.float32)
    dv = d_skip.astype(jnp.float32)

    def input_drive(u, d):
        return jnp.einsum('lgh,gph->lgp', u, bbr[d]), jnp.einsum('lgh,gph->lgp', u, bbi[d])

    def readout(s, d):
        re = jnp.einsum('lgp,ghp->lgh', s[0], cr[d]) - jnp.einsum('lgp,ghp->lgh', s[1], ci[d])
        return re.reshape(re.shape[0], D_MODEL)

    def per_sample(args):
        u_lat, u_ctx = args
        ul = u_lat.reshape(-1, S5_GROUPS, S5_GROUP_CH)
        uc = u_ctx.reshape(-1, S5_GROUPS, S5_GROUP_CH)
        y_lat = u_lat * dv
        y_ctx = u_ctx * dv if ctx_out else None
        for d, rev in ((0, False), (1, True)):
            s_c = diag_scan(lbr[d], lbi[d], *input_drive(uc, d), rev)
            end = 0 if rev else -1
            s_l = diag_scan(lbr[d], lbi[d], *input_drive(ul, d), rev, s0=(s_c[0][end], s_c[1][end]))
            y_lat = y_lat + readout(s_l, d)
            if ctx_out:
                y_ctx = y_ctx + readout(s_c, d)
        return (y_lat, y_ctx) if ctx_out else y_lat

    ys = lax.map(per_sample, (h_lat.astype(jnp.float32), h_ctx.astype(jnp.float32)))

    def glu(y):
        gy = jax.nn.gelu(y)
        return (gy @ w_a) * jax.nn.sigmoid(gy @ w_b)

    if ctx_out:
        y_lat, y_ctx = ys
        return glu(y_lat.astype(h_lat.dtype)), glu(y_ctx.astype(h_ctx.dtype))
    return glu(ys.astype(h_lat.dtype)), None


def setup_inputs(seed: int = 0) -> dict:
    key = jax.random.key(seed)
    ks = jax.random.split(key, 25)
    f32 = jnp.float32

    def nrm(k, shape, scale):
        return scale * jax.random.normal(k, shape, f32)

    n = jnp.arange(S5_STATE, dtype=f32)
    s5_shape = (N_ODD, 2, S5_GROUPS, S5_STATE)
    b_shape = (N_ODD, 2, S5_GROUPS, S5_STATE, S5_GROUP_CH)
    c_shape = (N_ODD, 2, S5_GROUPS, S5_GROUP_CH, S5_STATE)
    return {
        'x': nrm(ks[0], (BATCH, SEQ, D_MODEL), 1.0),
        'c': nrm(ks[1], (BATCH, D_MODEL), 1.0),
        'ctx': nrm(ks[2], (BATCH, CTX_LEN, D_MODEL), 1.0),
        'c_ctx': nrm(ks[3], (D_MODEL,), 1.0),
        'w_mod': nrm(ks[4], (DEPTH, D_MODEL, N_MOD * D_MODEL), 0.2 * D_MODEL ** -0.5),
        'b_mod': nrm(ks[5], (DEPTH, N_MOD * D_MODEL), 0.01),
        'norm_g': 1.0 + nrm(ks[6], (DEPTH, N_NORM, D_MODEL), 0.02),
        'ffn_w_gate': nrm(ks[7], (DEPTH, 2, D_MODEL, D_FF), D_MODEL ** -0.5),
        'ffn_w_up': nrm(ks[8], (DEPTH, 2, D_MODEL, D_FF), D_MODEL ** -0.5),
        'ffn_w_down': nrm(ks[9], (DEPTH, 2, D_FF, D_MODEL), D_FF ** -0.5),
        'mix_in': nrm(ks[10], (N_EVEN, D_MODEL, IN_COLS), D_MODEL ** -0.5),
        'conv_w': nrm(ks[11], (N_EVEN, CONV_W, MIX_A), CONV_W ** -0.5),
        'pool_w': nrm(ks[12], (N_EVEN, POOL_GROUPS, POOL_CH, POOL_CH), POOL_CH ** -0.5),
        'pool_scale': 1.0 + nrm(ks[13], (N_EVEN, MIX_B), 0.1),
        'mix_out': nrm(ks[14], (N_EVEN, MIX_A + MIX_B, D_MODEL), (MIX_A + MIX_B) ** -0.5),
        's5_lambda_re': -0.5 + nrm(ks[15], s5_shape, 0.01),
        's5_lambda_im': math.pi * n + nrm(ks[16], s5_shape, 0.01),
        's5_log_step': jax.random.uniform(ks[17], (N_ODD, 2, S5_GROUPS), f32, math.log(DT_MIN), math.log(DT_MAX)),
        's5_b_re': nrm(ks[18], b_shape, (2 * S5_GROUP_CH) ** -0.5),
        's5_b_im': nrm(ks[19], b_shape, (2 * S5_GROUP_CH) ** -0.5),
        's5_c_re': nrm(ks[20], c_shape, S5_STATE ** -0.5),
        's5_c_im': nrm(ks[21], c_shape, S5_STATE ** -0.5),
        's5_d': nrm(ks[22], (N_ODD, D_MODEL), 1.0),
        'glu_w_a': nrm(ks[23], (N_ODD, D_MODEL, D_MODEL), D_MODEL ** -0.5),
        'glu_w_b': nrm(ks[24], (N_ODD, D_MODEL, D_MODEL), D_MODEL ** -0.5),
    }


def reference(x, c, ctx, c_ctx, w_mod, b_mod, norm_g, ffn_w_gate, ffn_w_up, ffn_w_down, mix_in, conv_w, pool_w,
              pool_scale, mix_out, s5_lambda_re, s5_lambda_im, s5_log_step, s5_b_re, s5_b_im, s5_c_re, s5_c_im,
              s5_d, glu_w_a, glu_w_b):
    b = x.shape[0]
    x_lat, x_ctx = x, ctx
    sc = jax.nn.silu(c)
    scc = jax.nn.silu(c_ctx)
    for l in range(DEPTH):
        last = l == DEPTH - 1
        even = l % 2 == 0
        run_ctx_in = not (last and even)
        ctx_out = not last
        m_lat = (sc @ w_mod[l] + b_mod[l]).reshape(b, N_MOD, D_MODEL).transpose(1, 0, 2)[:, :, None, :]
        m_ctx = (scc @ w_mod[l] + b_mod[l]).reshape(N_MOD, 1, 1, D_MODEL)
        g = norm_g[l]
        x_lat = half_ffn(x_lat, m_lat, g, 0, ffn_w_gate[l, 0], ffn_w_up[l, 0], ffn_w_down[l, 0])
        if run_ctx_in:
            x_ctx = half_ffn(x_ctx, m_ctx, g, 0, ffn_w_gate[l, 0], ffn_w_up[l, 0], ffn_w_down[l, 0])
        h_lat = pre(x_lat, m_lat, g, 1)
        h_ctx = pre(x_ctx, m_ctx, g, 1) if run_ctx_in else None
        if even:
            e = l // 2
            y_lat = even_mixer(h_lat, mix_in[e], conv_w[e], pool_w[e], pool_scale[e], mix_out[e], True)
            y_ctx = even_mixer(h_ctx, mix_in[e], conv_w[e], pool_w[e], pool_scale[e], mix_out[e], False) if ctx_out else None
        else:
            o = l // 2
            y_lat, y_ctx = s5_mixer(h_lat, h_ctx, s5_lambda_re[o], s5_lambda_im[o], s5_log_step[o], s5_b_re[o],
                                    s5_b_im[o], s5_c_re[o], s5_c_im[o], s5_d[o], glu_w_a[o], glu_w_b[o], ctx_out)
        x_lat = post(x_lat, y_lat, m_lat, g, 1, 1.0)
        x_lat = half_ffn(x_lat, m_lat, g, 2, ffn_w_gate[l, 1], ffn_w_up[l, 1], ffn_w_down[l, 1])
        if ctx_out:
            x_ctx = post(x_ctx, y_ctx, m_ctx, g, 1, 1.0)
            x_ctx = half_ffn(x_ctx, m_ctx, g, 2, ffn_w_gate[l, 1], ffn_w_up[l, 1], ffn_w_down[l, 1])
    return x_lat
```

```cpp
#include <hip/hip_runtime.h>
#include <stdio.h>

#ifndef MK_PER_PHASE
#define MK_PER_PHASE 0
#endif

#define LAS __attribute__((address_space(3)))
#define GAS __attribute__((address_space(1)))
typedef unsigned short bf16_t;
typedef short bf16x8 __attribute__((ext_vector_type(8)));
typedef float f32x4 __attribute__((ext_vector_type(4)));
typedef float f32x2 __attribute__((ext_vector_type(2)));
typedef float f32x16 __attribute__((ext_vector_type(16)));
typedef unsigned u32x4 __attribute__((ext_vector_type(4)));
typedef unsigned u32x2 __attribute__((ext_vector_type(2)));
typedef GAS unsigned gu32;
typedef _Float16 f16x4 __attribute__((ext_vector_type(4)));

constexpr int D = 2048, BATCH = 8, SEQ = 4096, CTXL = 256, DFF = 5632, NMODV = 9 * D;
constexpr int MLAT = BATCH * SEQ, MCTX = BATCH * CTXL, MALL = MLAT + MCTX;
constexpr int MIXA = 1024, INCOLS = 4096, PCOLS = 3072;
constexpr float EPS = 1e-6f;
enum { I_X = 0, I_C, I_CTX, I_CCTX, I_WMOD, I_BMOD, I_NORMG, I_WG, I_WU, I_WD, I_MIXIN, I_CONVW, I_POOLW, I_POOLS, I_MIXOUT,
       I_LRE, I_LIM, I_LSTEP, I_BRE, I_BIM, I_CRE, I_CIM, I_S5D, I_GLUA, I_GLUB, N_IN };

constexpr size_t MiB = 1u << 20;
constexpr size_t WS_CTL = 0, CTL_ZERO_BYTES = 1 * MiB;
constexpr size_t WS_MOD = 2 * MiB;
constexpr size_t WS_PWT = 4 * MiB;
constexpr size_t WS_WIN = 8 * MiB;
constexpr size_t WS_WOUT = 24 * MiB;
constexpr size_t WS_WAB = 32 * MiB;
constexpr size_t WS_WGU = 48 * MiB;
constexpr size_t WS_WD = 224 * MiB;
constexpr size_t WS_XC = 312 * MiB;
constexpr size_t WS_TMP = 320 * MiB;
constexpr size_t WS_H = 328 * MiB;
constexpr size_t WS_Y = 464 * MiB;
constexpr size_t WS_HID = 600 * MiB;
constexpr size_t WS_X16 = 974 * MiB;
constexpr size_t WS_END = 1102 * MiB;
constexpr int CW_BAR = 4096;

constexpr int RING_BYTES = 131072;
constexpr int LDSCTL_OFF = RING_BYTES, MISC_OFF = LDSCTL_OFF + 320;
constexpr int LDS_BYTES = 163840;
constexpr int S5RING_OFF = 135168;
constexpr int NWAVES = 8;

typedef __bf16 bf16x2_t __attribute__((ext_vector_type(2)));
__device__ __forceinline__ unsigned cvt_pk_bf16(float lo, float hi) { const f32x2 v = {lo, hi}; return __builtin_bit_cast(unsigned, __builtin_convertvector(v, bf16x2_t)); }
__device__ __forceinline__ unsigned pk2(float lo, float hi) { return cvt_pk_bf16(lo, hi); }
__device__ __forceinline__ float bflo(unsigned w) { return __builtin_bit_cast(float, w << 16); }
__device__ __forceinline__ float bfhi(unsigned w) { return __builtin_bit_cast(float, w & 0xffff0000u); }
__device__ __forceinline__ float wave_sum(float v) {
#pragma unroll
    for (int o = 1; o < 64; o <<= 1) v += __shfl_xor(v, o);
    return v;
}
__device__ __forceinline__ float fast_sigmoid(float x) { return __builtin_amdgcn_rcpf(1.0f + __expf(-x)); }
#define LDS_WAIT() asm volatile("s_waitcnt lgkmcnt(0)" ::: "memory")
#define VM_WAIT() asm volatile("s_waitcnt vmcnt(0)" ::: "memory")
#define RLX_AGENT __ATOMIC_RELAXED, __HIP_MEMORY_SCOPE_AGENT

namespace pg8 {
#define PG8_LAS __attribute__((address_space(3)))
constexpr int BM = 256, BK = 64, HALF = 128, HTB = HALF * BK * 2, STAGE_BYTES = 8 * HTB, NXCD = 8, WGM = 8;
__host__ __device__ __forceinline__ int lds_byte(int r, int c) { const int st = (r >> 4) * 2 + (c >> 5), rr = r & 15, cc = c & 31, ob = rr * 64 + cc * 2; return st * 1024 + (ob ^ (((ob >> 9) & 1) << 5)); }
__host__ __device__ __forceinline__ void stage_rc(int b, int& R, int& C) { const int st = b / 1024, sb = b % 1024, swz = sb ^ (((sb >> 9) & 1) << 5); R = (st >> 1) * 16 + swz / 64; C = (st & 1) * 32 + (swz % 64) / 2; }
__host__ __device__ __forceinline__ int perm32(int rho) { const int n = rho >> 4, i = rho & 15; return 8 * (i >> 2) + 4 * n + (i & 3); }

struct Unit { int pm, pn; };
struct Gemm { const bf16_t* A; const bf16_t* Bt; int M, N, K, lda, ldb, a_pn_off; };

struct StaticOrder {
    int nM, nN, nwg, G, c, wgm, rev, xloc;
    __host__ __device__ void init(int M, int N, int G_, int c_, int wgm_ = WGM, int rev_ = 0, int xloc_ = 0) {
        nM = M / BM; nN = N / BM; nwg = nM * nN; G = G_; c = c_; wgm = wgm_; rev = rev_; xloc = (xloc_ && nM % NXCD == 0 && G_ % NXCD == 0) ? 1 : 0; }
    __host__ __device__ bool next(int i, Unit& u) const {
        const long L = (long)i * G + c; if (L >= nwg) return false;
        if (xloc) {
            const int xcd = (int)L % NXCD, off = (int)L / NXCD, pmx = nM / NXCD, nig = wgm * nN, gid = off / nig, fm = gid * wgm, gsz = (pmx - fm) < wgm ? (pmx - fm) : wgm, idx = off - gid * nig;
            u.pm = xcd * pmx + fm + idx % gsz; u.pn = idx / gsz;
        } else {
            int wgid = (int)L; { const int q = nwg / NXCD, r = nwg % NXCD, xcd = wgid % NXCD, off = wgid / NXCD; wgid = (xcd < r ? xcd * (q + 1) : r * (q + 1) + (xcd - r) * q) + off; }
            const int nig = wgm * nN, gid = wgid / nig, fm = gid * wgm, gsz = (nM - fm) < wgm ? (nM - fm) : wgm;
            u.pm = fm + ((wgid % nig) % gsz); u.pn = (wgid % nig) / gsz;
        }
        if (rev) u.pm = nM - 1 - u.pm; return true;
    }
    __device__ __forceinline__ void a_ready(const Unit&) const {}
    __device__ __forceinline__ void done(const Unit&) const {}
};

struct EpiBf16 {
    static constexpr bool PERM = true, AFTER_DRAIN = false;
    bf16_t* O; int ldc; const float* colscale;
    __device__ __forceinline__ void operator()(const f32x4 (&acc)[2][2][4][2], const Unit& u, int wr, int wc, int fr, int fq) const {
        const int row0 = u.pm * BM + wr * 64 + fr, col0 = u.pn * BM + wc * 32 + 8 * fq;
        f32x4 sv[2][2];
#pragma unroll
        for (int bj = 0; bj < 2; ++bj)
#pragma unroll
            for (int n = 0; n < 2; ++n) sv[bj][n] = colscale ? *(const f32x4*)(colscale + col0 + bj * HALF + 4 * n) : (f32x4){1.f, 1.f, 1.f, 1.f};
#pragma unroll
        for (int ai = 0; ai < 2; ++ai)
#pragma unroll
            for (int m = 0; m < 4; ++m) { bf16_t* rowp = O + (size_t)(row0 + ai * HALF + m * 16) * ldc + col0;
#pragma unroll
                for (int bj = 0; bj < 2; ++bj) { const f32x4 v0 = acc[ai][bj][m][0] * sv[bj][0], v1 = acc[ai][bj][m][1] * sv[bj][1];
                    u32x4 w; w.x = cvt_pk_bf16(v0[0], v0[1]); w.y = cvt_pk_bf16(v0[2], v0[3]); w.z = cvt_pk_bf16(v1[0], v1[1]); w.w = cvt_pk_bf16(v1[2], v1[3]);
                    *(u32x4*)(rowp + bj * HALF) = w; } }
    }
};
struct EpiInProj {
    static constexpr bool PERM = true, AFTER_DRAIN = false;
    bf16_t* O; int ldc;
    __device__ __forceinline__ void operator()(const f32x4 (&acc)[2][2][4][2], const Unit& u, int wr, int wc, int fr, int fq) const {
        const int row0 = u.pm * BM + wr * 64 + fr;
        if (u.pn >= 4 && u.pn < 12) {
            const int col0 = 1024 + (u.pn - 4) * HALF + wc * 32 + 8 * fq;
#pragma unroll
            for (int ai = 0; ai < 2; ++ai)
#pragma unroll
                for (int m = 0; m < 4; ++m) { bf16_t* rowp = O + (size_t)(row0 + ai * HALF + m * 16) * ldc + col0;
                    const f32x4 p0 = acc[ai][0][m][0] * acc[ai][1][m][0], p1 = acc[ai][0][m][1] * acc[ai][1][m][1];
                    u32x4 w; w.x = cvt_pk_bf16(p0[0], p0[1]); w.y = cvt_pk_bf16(p0[2], p0[3]); w.z = cvt_pk_bf16(p1[0], p1[1]); w.w = cvt_pk_bf16(p1[2], p1[3]);
                    *(u32x4*)rowp = w; }
        } else {
            const int col0 = (u.pn < 4 ? u.pn * BM : 2048 + (u.pn - 12) * BM) + wc * 32 + 8 * fq;
#pragma unroll
            for (int ai = 0; ai < 2; ++ai)
#pragma unroll
                for (int m = 0; m < 4; ++m) { bf16_t* rowp = O + (size_t)(row0 + ai * HALF + m * 16) * ldc + col0;
#pragma unroll
                    for (int bj = 0; bj < 2; ++bj) { const f32x4 v0 = acc[ai][bj][m][0], v1 = acc[ai][bj][m][1];
                        u32x4 w; w.x = cvt_pk_bf16(v0[0], v0[1]); w.y = cvt_pk_bf16(v0[2], v0[3]); w.z = cvt_pk_bf16(v1[0], v1[1]); w.w = cvt_pk_bf16(v1[2], v1[3]);
                        *(u32x4*)(rowp + bj * HALF) = w; } }
        }
    }
};
template <int MODE> struct EpiGated {
    static constexpr bool PERM = true, AFTER_DRAIN = false;
    bf16_t* O; int ldc;
    __device__ __forceinline__ void operator()(const f32x4 (&acc)[2][2][4][2], const Unit& u, int wr, int wc, int fr, int fq) const {
        const int row0 = u.pm * BM + wr * 64 + fr, col0 = u.pn * HALF + wc * 32 + 8 * fq;
#pragma unroll
        for (int ai = 0; ai < 2; ++ai)
#pragma unroll
            for (int m = 0; m < 4; ++m) { bf16_t* rowp = O + (size_t)(row0 + ai * HALF + m * 16) * ldc + col0;
                float o[8];
#pragma unroll
                for (int n = 0; n < 2; ++n)
#pragma unroll
                    for (int j = 0; j < 4; ++j) { const float a = acc[ai][0][m][n][j], b = acc[ai][1][m][n][j];
                        o[4 * n + j] = (MODE == 0) ? (a * fast_sigmoid(a)) * b : a * fast_sigmoid(b); }
                u32x4 w; w.x = cvt_pk_bf16(o[0], o[1]); w.y = cvt_pk_bf16(o[2], o[3]); w.z = cvt_pk_bf16(o[4], o[5]); w.w = cvt_pk_bf16(o[6], o[7]);
                *(u32x4*)rowp = w; }
    }
};

template <class Epi, class Sched, bool ALIGN_EPI = false, bool SP2 = false>
__device__ __forceinline__ void gemm_phase(PG8_LAS unsigned char* lds, const Gemm g, const Sched& S, const Epi& E, const int tid) {
    const int wid = __builtin_amdgcn_readfirstlane(tid >> 6), lane = tid & 63, wr = wid >> 2, wc = wid & 3, fr = lane & 15, fq = lane >> 4;
    const int K = g.K, nt = K / BK;
    unsigned voffA[2], voffB[2];
#pragma unroll
    for (int i = 0; i < 2; ++i) { int R, C; stage_rc(tid * 16 + i * 8192, R, C); const int Rb = Epi::PERM ? ((R & ~31) + perm32(R & 31)) : R;
        voffA[i] = (unsigned)(R * g.lda + C) * 2u; voffB[i] = (unsigned)(Rb * g.ldb + C) * 2u; }
    const size_t kstep = (size_t)(BK * 2);
    const size_t hstepA = (size_t)HALF * g.lda * 2, hstepB = (size_t)HALF * g.ldb * 2;
    const size_t tstepA = 2 * hstepA, tstepB = 2 * hstepB;
    const size_t pnA = (size_t)g.a_pn_off * 2;
    const unsigned ldsw = (unsigned)wid * 1024u;
    const int aoff = lds_byte(wr * 64 + fr, fq * 8), boff = lds_byte(wc * 32 + fr, fq * 8);
#define PG8_SA(b, h) (((b) * 2 + (h)) * HTB)
#define PG8_SB(b, h) ((4 + (b) * 2 + (h)) * HTB)
#define PG8_STAGE(bufoff, gbase, voff) do { _Pragma("unroll") for (int _i = 0; _i < 2; ++_i) \
        __builtin_amdgcn_global_load_lds((const unsigned*)((const char*)(gbase) + (voff)[_i]), (PG8_LAS unsigned*)(lds + (bufoff) + ldsw + _i * 8192), 16, 0, 0); } while (0)
#define PG8_LDA(dst, b, h) do { _Pragma("unroll") for (int m = 0; m < 4; ++m) _Pragma("unroll") for (int k = 0; k < 2; ++k) dst[m][k] = *(const PG8_LAS bf16x8*)(lds + PG8_SA(b, h) + aoff + m * 2048 + k * 1024); } while (0)
#define PG8_LDB(dst, b, h) do { _Pragma("unroll") for (int n = 0; n < 2; ++n) _Pragma("unroll") for (int k = 0; k < 2; ++k) dst[n][k] = *(const PG8_LAS bf16x8*)(lds + PG8_SB(b, h) + boff + n * 2048 + k * 1024); } while (0)
#define PG8_MMA(ai, bj, At, Bt) do { __builtin_amdgcn_s_setprio(1); _Pragma("unroll") for (int m = 0; m < 4; ++m) _Pragma("unroll") for (int n = 0; n < 2; ++n) _Pragma("unroll") for (int k = 0; k < 2; ++k) \
        acc[ai][bj][m][n] = __builtin_amdgcn_mfma_f32_16x16x32_bf16(Bt[n][k], At[m][k], acc[ai][bj][m][n], 0, 0, 0); __builtin_amdgcn_s_setprio(0); } while (0)
#define PG8_WAIT_V(n) asm volatile("s_waitcnt vmcnt(" #n ")" ::: "memory")
#define PG8_WAIT_L(n) asm volatile("s_waitcnt lgkmcnt(" #n ")" ::: "memory")
#define PG8_BAR __builtin_amdgcn_s_barrier()
#define PG8_SCHED __builtin_amdgcn_sched_barrier(0)
    Unit cur, nxt; int ui = 0;
    if (!S.next(0, cur)) return;
    f32x4 acc[2][2][4][2];
#pragma unroll
    for (int a = 0; a < 2; ++a)
#pragma unroll
        for (int b = 0; b < 2; ++b)
#pragma unroll
            for (int m = 0; m < 4; ++m)
#pragma unroll
                for (int n = 0; n < 2; ++n) acc[a][b][m][n] = (f32x4){0.f, 0.f, 0.f, 0.f};
    bf16x8 At[4][2], B0[2][2], B1[2][2];
    const char* cA = (const char*)g.A + (size_t)cur.pm * tstepA + (size_t)cur.pn * pnA; const char* cB = (const char*)g.Bt + (size_t)cur.pn * tstepB;
    S.a_ready(cur);
    if constexpr (SP2) {
        PG8_STAGE(PG8_SB(0, 0), cB, voffB); PG8_STAGE(PG8_SB(0, 1), cB + hstepB, voffB); PG8_STAGE(PG8_SA(0, 0), cA, voffA); PG8_STAGE(PG8_SA(0, 1), cA + hstepA, voffA);
        if (wr == 1) PG8_BAR;
        PG8_WAIT_V(2); PG8_BAR;
        PG8_STAGE(PG8_SB(1, 0), cB + kstep, voffB); PG8_STAGE(PG8_SA(1, 0), cA + kstep, voffA); PG8_STAGE(PG8_SB(1, 1), cB + hstepB + kstep, voffB);
        PG8_WAIT_V(6); PG8_BAR;
    } else {
        PG8_STAGE(PG8_SB(0, 0), cB, voffB); PG8_STAGE(PG8_SA(0, 0), cA, voffA); PG8_STAGE(PG8_SB(0, 1), cB + hstepB, voffB); PG8_STAGE(PG8_SA(0, 1), cA + hstepA, voffA);
        if (wr == 1) PG8_BAR;
        PG8_WAIT_V(4); PG8_BAR;
        PG8_STAGE(PG8_SB(1, 0), cB + kstep, voffB); PG8_STAGE(PG8_SA(1, 0), cA + kstep, voffA); PG8_STAGE(PG8_SB(1, 1), cB + hstepB + kstep, voffB);
        PG8_WAIT_V(6); PG8_BAR;
    }
    for (;;) {
        const bool has_next = S.next(ui + 1, nxt);
        const char* nA = has_next ? (const char*)g.A + (size_t)nxt.pm * tstepA + (size_t)nxt.pn * pnA : cA; const char* nB = has_next ? (const char*)g.Bt + (size_t)nxt.pn * tstepB : cB;
        for (int t = 0; t < nt; t += 2) {
            const bool last = (t == nt - 2);
            const char* a1 = cA + (size_t)(t + 1) * kstep;
            const char* a2 = last ? nA : cA + (size_t)(t + 2) * kstep; const char* b2 = last ? nB : cB + (size_t)(t + 2) * kstep;
            const char* a3 = a2 + kstep; const char* b3 = b2 + kstep;
            if (last && has_next) S.a_ready(nxt);
            if constexpr (SP2) {
            PG8_LDB(B0, 0, 0); PG8_LDB(B1, 0, 1); PG8_SCHED; PG8_LDA(At, 0, 0); PG8_STAGE(PG8_SA(1, 1), a1 + hstepA, voffA);
            PG8_WAIT_V(8); PG8_WAIT_L(0); PG8_BAR; PG8_MMA(0, 0, At, B0); PG8_MMA(0, 1, At, B1); PG8_BAR; PG8_SCHED;
            PG8_LDA(At, 0, 1); PG8_STAGE(PG8_SB(0, 0), b2, voffB); PG8_STAGE(PG8_SB(0, 1), b2 + hstepB, voffB); PG8_STAGE(PG8_SA(0, 0), a2, voffA);
            PG8_WAIT_V(8); PG8_WAIT_L(0); PG8_BAR; PG8_MMA(1, 0, At, B0); PG8_MMA(1, 1, At, B1); PG8_BAR; PG8_SCHED;
            PG8_LDB(B0, 1, 0); PG8_LDB(B1, 1, 1); PG8_SCHED; PG8_LDA(At, 1, 0); PG8_STAGE(PG8_SA(0, 1), a2 + hstepA, voffA);
            PG8_WAIT_V(8); PG8_WAIT_L(0); PG8_BAR; PG8_MMA(0, 0, At, B0); PG8_MMA(0, 1, At, B1); PG8_BAR; PG8_SCHED;
            PG8_LDA(At, 1, 1); PG8_STAGE(PG8_SB(1, 0), b3, voffB); PG8_STAGE(PG8_SB(1, 1), b3 + hstepB, voffB); PG8_STAGE(PG8_SA(1, 0), a3, voffA);
            PG8_WAIT_V(8); PG8_WAIT_L(0); PG8_BAR; PG8_MMA(1, 0, At, B0); PG8_MMA(1, 1, At, B1); PG8_BAR; PG8_SCHED;
            } else {
            PG8_LDB(B0, 0, 0); PG8_SCHED; PG8_LDA(At, 0, 0); PG8_STAGE(PG8_SA(1, 1), a1 + hstepA, voffA);
            PG8_WAIT_L(8); PG8_BAR; PG8_WAIT_L(0); PG8_MMA(0, 0, At, B0); PG8_BAR; PG8_SCHED;
            PG8_LDB(B1, 0, 1); PG8_STAGE(PG8_SB(0, 0), b2, voffB);
            PG8_BAR; PG8_WAIT_L(0); PG8_MMA(0, 1, At, B1); PG8_BAR;
            PG8_LDA(At, 0, 1); PG8_STAGE(PG8_SA(0, 0), a2, voffA);
            PG8_BAR; PG8_WAIT_L(0); PG8_MMA(1, 0, At, B0); PG8_BAR; PG8_SCHED;
            PG8_STAGE(PG8_SB(0, 1), b2 + hstepB, voffB);
            PG8_WAIT_V(6); PG8_BAR; PG8_MMA(1, 1, At, B1); PG8_BAR;
            PG8_LDB(B0, 1, 0); PG8_SCHED; PG8_LDA(At, 1, 0); PG8_STAGE(PG8_SA(0, 1), a2 + hstepA, voffA);
            PG8_WAIT_L(8); PG8_BAR; PG8_WAIT_L(0); PG8_MMA(0, 0, At, B0); PG8_BAR; PG8_SCHED;
            PG8_LDB(B1, 1, 1); PG8_STAGE(PG8_SB(1, 0), b3, voffB);
            PG8_BAR; PG8_WAIT_L(0); PG8_MMA(0, 1, At, B1); PG8_BAR;
            PG8_LDA(At, 1, 1); PG8_STAGE(PG8_SA(1, 0), a3, voffA);
            PG8_BAR; PG8_WAIT_L(0); PG8_MMA(1, 0, At, B0); PG8_BAR; PG8_SCHED;
            PG8_STAGE(PG8_SB(1, 1), b3 + hstepB, voffB);
            PG8_WAIT_V(6); PG8_BAR; PG8_MMA(1, 1, At, B1); PG8_BAR;
            }
        }
        if constexpr (ALIGN_EPI) { if (wr == 0) PG8_BAR; }
        if constexpr (!Epi::AFTER_DRAIN) { E(acc, cur, wr, wc, fr, fq); S.done(cur); }
        if (!has_next) break;
#pragma unroll
        for (int a = 0; a < 2; ++a)
#pragma unroll
            for (int b = 0; b < 2; ++b)
#pragma unroll
                for (int m = 0; m < 4; ++m)
#pragma unroll
                    for (int n = 0; n < 2; ++n) acc[a][b][m][n] = (f32x4){0.f, 0.f, 0.f, 0.f};
        cur = nxt; cA = nA; cB = nB; ++ui;
        if constexpr (ALIGN_EPI) { if (wr == 1) PG8_BAR; }
    }
    PG8_WAIT_V(0);
    if constexpr (!ALIGN_EPI) { if (wr == 0) PG8_BAR; }
    PG8_BAR;
#undef PG8_SA
#undef PG8_SB
#undef PG8_STAGE
#undef PG8_LDA
#undef PG8_LDB
#undef PG8_MMA
#undef PG8_WAIT_V
#undef PG8_WAIT_L
#undef PG8_BAR
#undef PG8_SCHED
}
}

#define XB_TMO      128
#define XB_XCNT(j)  (256  + 64 * (j))
#define XB_XSUB(j)  (1280 + 64 * (j))
#define XB_XGEN(j)  (2304 + 64 * (j))
#define XB_TOP      3328
#define XB_TOPGEN   3392
#define XCD_BAR_WORDS 3456
#define XB_SPIN_CAP (1u << 18)

__device__ __forceinline__ unsigned xb_ld(unsigned* p)              { return __hip_atomic_load(p, __ATOMIC_RELAXED, __HIP_MEMORY_SCOPE_AGENT); }
__device__ __forceinline__ unsigned xb_add(unsigned* p, unsigned v) { return __hip_atomic_fetch_add(p, v, __ATOMIC_RELAXED, __HIP_MEMORY_SCOPE_AGENT); }
__device__ __forceinline__ unsigned xb_xcc_id() { return (unsigned)__builtin_amdgcn_s_getreg((3 << 11) | 20) & 0xFu; }
#define XB_SPIN(cond, bar) do { unsigned _sp = 0; while (cond) { __builtin_amdgcn_s_sleep(1); \
    if ((++_sp & 255u) == 0u) { if (xb_ld(&(bar)[XB_TMO])) break; if (_sp > XB_SPIN_CAP) { atomicAdd(&(bar)[XB_TMO], 1u); break; } } } } while (0)

struct XcdBarrier { unsigned* bar; unsigned x; volatile LAS unsigned* st; };

__device__ __forceinline__ XcdBarrier xcd_barrier_post(unsigned* bar, volatile LAS unsigned* st) {
    XcdBarrier b; b.bar = bar; b.x = xb_xcc_id(); b.st = st;
    if (threadIdx.x == 0) (void)xb_add(&bar[XB_XCNT(b.x)], 1u);
    return b;
}
__device__ __forceinline__ void xcd_barrier_complete(unsigned* bar, unsigned x, unsigned& nloc, unsigned& nx) {
    const unsigned G = gridDim.x * gridDim.y * gridDim.z;
    unsigned sum, cnt, mine, sp = 0u;
    for (;;) {
        sum = 0u; cnt = 0u; mine = 0u;
#pragma unroll
        for (unsigned j = 0; j < 16; ++j) { const unsigned c = xb_ld(&bar[XB_XCNT(j)]); sum += c; cnt += (c > 0u) ? 1u : 0u; mine = (j == x) ? c : mine; }
        if (sum == G) break;
        __builtin_amdgcn_s_sleep(1);
        if ((++sp & 255u) == 0u) { if (xb_ld(&bar[XB_TMO])) break; if (sp > XB_SPIN_CAP) { atomicAdd(&bar[XB_TMO], 1u); break; } }
    }
    nloc = mine > 0u ? mine : 1u; nx = cnt > 0u ? cnt : 1u;
}
__device__ __forceinline__ void xcd_barrier(const XcdBarrier& b) {
    asm volatile("s_waitcnt vmcnt(0)" ::: "memory");
    __syncthreads();
    if (threadIdx.x == 0) {
        unsigned* bar = b.bar;
        __builtin_amdgcn_s_waitcnt(0);
        unsigned nloc = b.st[0], nx = b.st[1];
        if (nloc == 0u) { xcd_barrier_complete(bar, b.x, nloc, nx); b.st[0] = nloc; b.st[1] = nx; }
        const unsigned old = xb_add(&bar[XB_XSUB(b.x)], 1u);
        const unsigned gen = old / nloc;
        if (old + 1u == (gen + 1u) * nloc) {
            __builtin_amdgcn_fence(__ATOMIC_RELEASE, "agent");
            asm volatile("s_waitcnt vmcnt(0)" ::: "memory");
            const unsigned og = xb_add(&bar[XB_TOP], 1u);
            const unsigned tg = og / nx;
            if (og + 1u == (tg + 1u) * nx) xb_add(&bar[XB_TOPGEN], 1u);
            else XB_SPIN(xb_ld(&bar[XB_TOPGEN]) == tg, bar);
            __builtin_amdgcn_fence(__ATOMIC_ACQUIRE, "agent");
            xb_add(&bar[XB_XGEN(b.x)], 1u);
            asm volatile("s_waitcnt vmcnt(0)" ::: "memory");
        } else {
            XB_SPIN(xb_ld(&bar[XB_XGEN(b.x)]) == gen, bar);
            __builtin_amdgcn_fence(__ATOMIC_ACQUIRE, "agent");
            asm volatile("s_waitcnt vmcnt(0)" ::: "memory");
        }
    }
    __syncthreads();
}

struct Args { const float* in[N_IN]; float* out; unsigned char* ws; int ph_lo, ph_hi, li, pad; };
struct Frame { LAS unsigned char* lds; int tid, lane, wave, vcu, G; };
typedef const __attribute__((address_space(4))) Args* ArgsP;


__device__ __forceinline__ void p0_transpose_item(const float* W, int N, bf16_t* WT, int Kdst, int k0, int n0, int drow0, LAS float* scr, int lane) {
#pragma unroll
    for (int i = 0; i < 32; ++i) { const int kk = 2 * i + (lane >> 5); scr[kk * 33 + (lane & 31)] = W[(size_t)(k0 + kk) * N + n0 + (lane & 31)]; }
    LDS_WAIT(); asm volatile("" ::: "memory");
    const int c = lane & 7;
#pragma unroll
    for (int j = 0; j < 4; ++j) { const int n = (lane >> 3) + 8 * j; const LAS float* s = scr + (8 * c) * 33 + n;
        u32x4 o; o.x = pk2(s[0 * 33], s[1 * 33]); o.y = pk2(s[2 * 33], s[3 * 33]); o.z = pk2(s[4 * 33], s[5 * 33]); o.w = pk2(s[6 * 33], s[7 * 33]);
        *(GAS u32x4*)(WT + (size_t)(drow0 + n) * Kdst + k0 + 8 * c) = o; }
    LDS_WAIT(); asm volatile("" ::: "memory");
}
__device__ __forceinline__ int ilv_row(int n, int hi) { return 256 * (n >> 7) + (n & 127) + 128 * hi; }

constexpr int CV_FFN = 5632, CV_FFN_ALL = 12 * CV_FFN, CV_MIX0 = CV_FFN_ALL, CV_MIX1 = CV_MIX0 + 4096 + 2048 + 128, CV_GLU1 = CV_MIX1 + 4096;
__device__ __forceinline__ void convert_items(ArgsP ap, int lo, int hi, int wrank, int nw, LAS float* scr, int lane) {
    unsigned char* ws = ap->ws;
    for (int it = lo + wrank; it < hi; it += nw) {
        int r = it;
        if (r < CV_FFN_ALL) {
            const int mat = r / CV_FFN, item = r % CV_FFN, lf = mat / 3, kind = mat % 3;
            if (kind < 2) {
                const float* W = ap->in[kind == 0 ? I_WG : I_WU] + (size_t)lf * D * DFF;
                const int kb = item / 176, nb = item % 176, n0 = 32 * nb;
                p0_transpose_item(W, DFF, (bf16_t*)(ws + WS_WGU) + (size_t)lf * (2 * DFF) * D, D, 64 * kb, n0, ilv_row(n0, kind), scr, lane);
            } else {
                const float* W = ap->in[I_WD] + (size_t)lf * DFF * D;
                const int kb = item / 64, nb = item % 64, n0 = 32 * nb;
                p0_transpose_item(W, D, (bf16_t*)(ws + WS_WD) + (size_t)lf * D * DFF, DFF, 64 * kb, n0, n0, scr, lane);
            }
            continue;
        }
        r -= CV_FFN_ALL;
        if (r < 4096) { const int kb = r / 128, nb = r % 128, n0 = 32 * nb, sec = n0 >> 10, j0 = n0 & 1023;
            const int drow = (sec == 1 || sec == 2) ? 1024 + ilv_row(j0, sec - 1) : n0;
            p0_transpose_item(ap->in[I_MIXIN], INCOLS, (bf16_t*)(ws + WS_WIN), D, 64 * kb, n0, drow, scr, lane); continue; }
        r -= 4096;
        if (r < 2048) { const int kb = r / 64, nb = r % 64;
            p0_transpose_item(ap->in[I_MIXOUT], D, (bf16_t*)(ws + (kb < 16 ? WS_WOUT : WS_TMP)), D, 64 * kb, 32 * nb, 32 * nb, scr, lane); continue; }
        r -= 2048;
        if (r < 128) {
#pragma unroll
            for (int i = 0; i < 8; ++i) { const int row = 8 * r + i;
                const f32x4 v = *(const f32x4*)(ap->in[I_POOLW] + (size_t)row * 256 + 4 * lane) * *(const f32x4*)(ap->in[I_POOLS] + (row >> 8) * 256 + 4 * lane);
                u32x2 w; w.x = pk2(v.x, v.y); w.y = pk2(v.z, v.w); *(GAS u32x2*)((bf16_t*)(ws + WS_PWT) + (size_t)row * 256 + 4 * lane) = w; }
            continue; }
        r -= 128;
        { const int which = r / 2048, item = r % 2048, kb = item / 64, nb = item % 64, n0 = 32 * nb;
          p0_transpose_item(ap->in[which == 0 ? I_GLUA : I_GLUB], D, (bf16_t*)(ws + WS_WAB), D, 64 * kb, n0, ilv_row(n0, which), scr, lane); }
    }
}
__device__ __forceinline__ void convert_in_tail(ArgsP ap, Frame& F, int first_idle, int lo0, int hi0, int lo1, int hi1) {
    if ((int)blockIdx.x < first_idle) return;
    LAS float* scr = (LAS float*)(F.lds + F.wave * 16384);
    const int wrank = ((int)blockIdx.x - first_idle) * NWAVES + F.wave, nw = (F.G - first_idle) * NWAVES;
    convert_items(ap, lo0, hi0, wrank, nw, scr, F.lane);
    convert_items(ap, lo1, hi1, wrank, nw, scr, F.lane);
}
__device__ __forceinline__ void p0_prologue(ArgsP ap, Frame& F) {
    unsigned char* ws = ap->ws;
    convert_items(ap, 0, 3 * CV_FFN, F.vcu * NWAVES + F.wave, F.G * NWAVES, (LAS float*)(F.lds + F.wave * 16384), F.lane);
    __syncthreads();
    {
        LAS float* sc = (LAS float*)(F.lds);
        LAS float* red = (LAS float*)(F.lds + 73728);
        if ((int)blockIdx.x < 288) {
            for (int idx = F.tid; idx < 9 * D; idx += NWAVES * 64) { const int r = idx >> 11, k = idx & (D - 1);
                const float v = r < 8 ? ap->in[I_C][r * D + k] : ap->in[I_CCTX][k]; sc[idx] = v / (1.0f + expf(-v)); }
        }
        __syncthreads();
        float* MOD = (float*)(ws + WS_MOD);
        for (int unit = blockIdx.x; unit < 288; unit += F.G) {
            const int l = unit / 144, n0 = (unit % 144) * 128, kw = F.wave * 256;
            const float* wrow = ap->in[I_WMOD] + ((size_t)l * D + kw) * NMODV + n0;
            const unsigned loff = 2u * (unsigned)F.lane;
            f32x2 acc[9];
#pragma unroll
            for (int r = 0; r < 9; ++r) acc[r] = (f32x2){0.f, 0.f};
            f32x2 wa[8], wb[8];
#define GV_LOAD(dst, k4b) do { _Pragma("unroll") for (int i = 0; i < 8; ++i) dst[i] = *(const f32x2*)(wrow + (size_t)(4 * (k4b) + i) * NMODV + loff); } while (0)
#define GV_COMP(src, k4b) do { _Pragma("unroll") for (int q = 0; q < 2; ++q) { _Pragma("unroll") for (int r = 0; r < 9; ++r) { \
                const f32x4 s4 = *(const LAS f32x4*)(sc + r * D + kw + 4 * ((k4b) + q)); \
                acc[r] += src[4 * q] * s4[0]; acc[r] += src[4 * q + 1] * s4[1]; acc[r] += src[4 * q + 2] * s4[2]; acc[r] += src[4 * q + 3] * s4[3]; } __builtin_amdgcn_sched_barrier(0); } } while (0)
            GV_LOAD(wa, 0);
            for (int kb = 0; kb < 64; kb += 4) {
                GV_LOAD(wb, kb + 2); __builtin_amdgcn_sched_barrier(0);
                GV_COMP(wa, kb); __builtin_amdgcn_sched_barrier(0);
                { const int kn = (kb + 4 < 64) ? kb + 4 : 62; GV_LOAD(wa, kn); }
                __builtin_amdgcn_sched_barrier(0);
                GV_COMP(wb, kb + 2); __builtin_amdgcn_sched_barrier(0);
            }
#undef GV_LOAD
#undef GV_COMP
#pragma unroll
            for (int r = 0; r < 9; ++r) *(LAS f32x2*)(red + (F.wave * 9 + r) * 128 + 2 * F.lane) = acc[r];
            __syncthreads();
            for (int o = F.tid; o < 9 * 128; o += NWAVES * 64) { const int r = o >> 7, cc = o & 127; float s = ap->in[I_BMOD][l * NMODV + n0 + cc];
#pragma unroll
                for (int w = 0; w < 8; ++w) s += red[(w * 9 + r) * 128 + cc];
                MOD[(size_t)(l * 9 + r) * NMODV + n0 + cc] = s; }
            __syncthreads();
        }
    }
}

struct NormP { const void* src_lat; const void* src_ctx; void* dst_lat; void* dst_ctx; int src_f32, dst_f32; const bf16_t* y; bf16_t* h;
               const float* mod_post; const float* g_post; int ipost; float weight;
               const float* mod_pre; const float* g_pre; int ipre; int M, has_post, has_pre; };
__device__ __forceinline__ void norm_phase(Frame& F, const NormP& p) {
    const int gw = F.vcu * NWAVES + F.wave, NGW = F.G * NWAVES;
    const int rpw = (p.M + NGW - 1) / NGW;
    const int R0 = gw * rpw, R1 = (R0 + rpw) < p.M ? (R0 + rpw) : p.M;
    int rcur = -1;
    f32x4 Ap[8], Aq[8], Bq[8];
#pragma unroll
    for (int j = 0; j < 8; ++j) { Ap[j] = (f32x4){0.f, 0.f, 0.f, 0.f}; Aq[j] = Ap[j]; Bq[j] = Ap[j]; }
    for (int R = R0; R < R1; ++R) {
        const int r = R < MLAT ? (R >> 12) : 8;
        if (r != rcur) {
            rcur = r;
            if (p.has_post) { const f32x4* gt = (const f32x4*)(p.mod_post + (size_t)r * NMODV + (3 * p.ipost + 2) * D) + F.lane; const f32x4* gp = (const f32x4*)p.g_post + F.lane;
#pragma unroll
                for (int j = 0; j < 8; ++j) Ap[j] = gt[64 * j] * gp[64 * j] * p.weight; }
            if (p.has_pre) { const f32x4* scl = (const f32x4*)(p.mod_pre + (size_t)r * NMODV + (3 * p.ipre + 1) * D) + F.lane; const f32x4* sh = (const f32x4*)(p.mod_pre + (size_t)r * NMODV + (3 * p.ipre) * D) + F.lane;
                const f32x4* gq = (const f32x4*)p.g_pre + F.lane;
#pragma unroll
                for (int j = 0; j < 8; ++j) { Aq[j] = gq[64 * j] * (scl[64 * j] + 1.0f); Bq[j] = sh[64 * j]; } }
        }
        const size_t roff = R < MLAT ? (size_t)R * D : (size_t)(R - MLAT) * D;
        const void* xsb = R < MLAT ? p.src_lat : p.src_ctx; void* xdb = R < MLAT ? p.dst_lat : p.dst_ctx;
        f32x4 x[8];
        if (p.src_f32) {
#pragma unroll
            for (int j = 0; j < 8; ++j) x[j] = ((const f32x4*)((const float*)xsb + roff))[F.lane + 64 * j];
        } else {
            f16x4 xh[8];
#pragma unroll
            for (int j = 0; j < 8; ++j) xh[j] = ((const f16x4*)((const _Float16*)xsb + roff))[F.lane + 64 * j];
#pragma unroll
            for (int j = 0; j < 8; ++j) x[j] = __builtin_convertvector(xh[j], f32x4);
        }
        if (p.has_post) {
            u32x2 yw[8];
#pragma unroll
            for (int j = 0; j < 8; ++j) yw[j] = ((const u32x2*)(p.y + (size_t)R * D))[F.lane + 64 * j];
            f32x4 yv[8]; float ss = 0.f;
#pragma unroll
            for (int j = 0; j < 8; ++j) { yv[j] = (f32x4){bflo(yw[j].x), bfhi(yw[j].x), bflo(yw[j].y), bfhi(yw[j].y)};
                ss += (yv[j].x * yv[j].x + yv[j].y * yv[j].y) + (yv[j].z * yv[j].z + yv[j].w * yv[j].w); }
            const float rstd = 1.0f / sqrtf(wave_sum(ss) * (1.0f / D) + EPS);
#pragma unroll
            for (int j = 0; j < 8; ++j) x[j] = x[j] + Ap[j] * (yv[j] * rstd);
            if (p.dst_f32) {
#pragma unroll
                for (int j = 0; j < 8; ++j) ((f32x4*)((float*)xdb + roff))[F.lane + 64 * j] = x[j];
            } else {
#pragma unroll
                for (int j = 0; j < 8; ++j) { const f16x4 xh = __builtin_convertvector(x[j], f16x4); ((f16x4*)((_Float16*)xdb + roff))[F.lane + 64 * j] = xh; x[j] = __builtin_convertvector(xh, f32x4); }
            }
        }
        if (p.has_pre) {
            float ss = 0.f;
#pragma unroll
            for (int j = 0; j < 8; ++j) ss += (x[j].x * x[j].x + x[j].y * x[j].y) + (x[j].z * x[j].z + x[j].w * x[j].w);
            const float rstd = 1.0f / sqrtf(wave_sum(ss) * (1.0f / D) + EPS);
            u32x2* ho = (u32x2*)(p.h + (size_t)R * D);
#pragma unroll
            for (int j = 0; j < 8; ++j) { const f32x4 v = (x[j] * rstd) * Aq[j] + Bq[j]; u32x2 w; w.x = pk2(v.x, v.y); w.y = pk2(v.z, v.w); ho[F.lane + 64 * j] = w; }
        }
    }
}

__device__ __forceinline__ f32x4 ld_bf4(const bf16_t* p) { const u32x2 w = *(const u32x2*)p; return (f32x4){bflo(w.x), bfhi(w.x), bflo(w.y), bfhi(w.y)}; }
__device__ __forceinline__ void st_bf4(bf16_t* p, f32x4 v) { u32x2 w; w.x = pk2(v.x, v.y); w.y = pk2(v.z, v.w); *(u32x2*)p = w; }
__device__ __forceinline__ void stencil_phase(ArgsP ap, Frame& F) {
    const bf16_t* P = (const bf16_t*)(ap->ws + WS_HID);
    bf16_t* Y2 = (bf16_t*)(ap->ws + WS_H);
    const int gw = F.vcu * NWAVES + F.wave, NGW = F.G * NWAVES;
    constexpr int SEG = 136, NSEG = MALL / SEG;
    static_assert(NSEG * SEG == MALL, "segment size");
    for (int wu = gw; wu < NSEG * 8; wu += NGW) {
        const int seg = wu >> 3, cb = wu & 7, R0 = seg * SEG;
        if (cb < 4) {
            const int ch = 256 * cb + 4 * F.lane;
            const f32x4 w0 = *(const f32x4*)(ap->in[I_CONVW] + ch), w1 = *(const f32x4*)(ap->in[I_CONVW] + MIXA + ch), w2 = *(const f32x4*)(ap->in[I_CONVW] + 2 * MIXA + ch);
            const f32x4 z = (f32x4){0.f, 0.f, 0.f, 0.f};
            const bf16_t* CV = P + MIXA + ch; const bf16_t* GB = P + ch;
            f32x4 prev = (R0 > 0) ? ld_bf4(CV + (size_t)(R0 - 1) * PCOLS) : z;
            f32x4 cur = ld_bf4(CV + (size_t)R0 * PCOLS);
            for (int Rb = R0; Rb < R0 + SEG; Rb += 8) {
                u32x2 nr[8], gr[8];
#pragma unroll
                for (int i = 0; i < 8; ++i) { const int Rn = (Rb + i + 1 < MALL) ? Rb + i + 1 : MALL - 1;
                    nr[i] = *(const u32x2*)(CV + (size_t)Rn * PCOLS); gr[i] = *(const u32x2*)(GB + (size_t)(Rb + i) * PCOLS); }
#pragma unroll
                for (int i = 0; i < 8; ++i) { const int R = Rb + i;
                    const int slo = R < MLAT ? (R & ~(SEQ - 1)) : MLAT + ((R - MLAT) & ~(CTXL - 1)), shi = slo + (R < MLAT ? SEQ : CTXL);
                    const f32x4 nxt = (R + 1 < MALL) ? (f32x4){bflo(nr[i].x), bfhi(nr[i].x), bflo(nr[i].y), bfhi(nr[i].y)} : z;
                    const f32x4 gb = (f32x4){bflo(gr[i].x), bfhi(gr[i].x), bflo(gr[i].y), bfhi(gr[i].y)};
                    const f32x4 pv = (R - 1 >= slo) ? prev : z, nx = (R + 1 < shi) ? nxt : z;
                    st_bf4(Y2 + (size_t)R * D + ch, gb * (w0 * pv + w1 * cur + w2 * nx));
                    prev = cur; cur = nxt; }
            }
        } else {
            const int gi = cb - 4, half = 1 << gi, ch = 256 * gi + 4 * F.lane;
            const bf16_t* U = P + 2 * MIXA + ch;
            f32x4 S = (f32x4){0.f, 0.f, 0.f, 0.f};
            for (int Rb = R0; Rb < R0 + SEG; Rb += 8) {
                u32x2 ur[8], ar[8], sr[8];
#pragma unroll
                for (int i = 0; i < 8; ++i) { const int R = Rb + i, ra = (R + half < MALL) ? R + half : MALL - 1, rs = (R - half > 0) ? R - half : 0;
                    ur[i] = *(const u32x2*)(U + (size_t)R * PCOLS); ar[i] = *(const u32x2*)(U + (size_t)ra * PCOLS); sr[i] = *(const u32x2*)(U + (size_t)rs * PCOLS); }
#pragma unroll
                for (int i = 0; i < 8; ++i) { const int R = Rb + i;
                    const int plo = R < MLAT ? (R & ~63) : MLAT + ((R - MLAT) & ~(CTXL - 1)), phi = plo + (R < MLAT ? 64 : CTXL);
                    const int lo = (R - half) > plo ? (R - half) : plo, hi = (R + half) < phi ? (R + half) : phi;
                    if (R == R0 || R == plo) {
                        S = (f32x4){0.f, 0.f, 0.f, 0.f};
                        for (int k = lo; k < hi; ++k) S += ld_bf4(U + (size_t)k * PCOLS);
                    }
                    const float inv = 1.0f / (float)(hi - lo);
                    const f32x4 u = (f32x4){bflo(ur[i].x), bfhi(ur[i].x), bflo(ur[i].y), bfhi(ur[i].y)};
                    st_bf4(Y2 + (size_t)R * D + MIXA + ch, S * inv - u);
                    if (R + half < phi) S += (f32x4){bflo(ar[i].x), bfhi(ar[i].x), bflo(ar[i].y), bfhi(ar[i].y)};
                    if (R - half >= plo) S -= (f32x4){bflo(sr[i].x), bfhi(sr[i].x), bflo(sr[i].y), bfhi(sr[i].y)};
                }
            }
        }
    }
}

__device__ __forceinline__ void s5_disc(float lre, float lim, float dt, float& lbr, float& lbi, float& fr, float& fi) {
    const float mag = expf(lre * dt); float sn, cs; sincosf(lim * dt, &sn, &cs);
    lbr = mag * cs; lbi = mag * sn;
    const float den = lre * lre + lim * lim, nr = lbr - 1.0f;
    fr = (nr * lre + lbi * lim) / den; fi = (lbi * lre - nr * lim) / den;
}
__device__ __forceinline__ int s5_row(int b, int d, int c, int m) { const int isl = c >= 8, L = isl ? SEQ : CTXL, base = isl ? b * SEQ : MLAT + b * CTXL, pos = 32 * (isl ? c - 8 : c) + m; return base + (d ? L - 1 - pos : pos); }
__device__ __forceinline__ void s5_drive_scan(const bf16x8 Uc, const bf16x8 (&Bq)[4], float lbr, float lbi, float& sre, float& sim, unsigned (&pk)[32]) {
    f32x16 acc[4];
#pragma unroll
    for (int q = 0; q < 4; ++q) { acc[q] = (f32x16){0.f, 0.f, 0.f, 0.f, 0.f, 0.f, 0.f, 0.f, 0.f, 0.f, 0.f, 0.f, 0.f, 0.f, 0.f, 0.f};
        acc[q] = __builtin_amdgcn_mfma_f32_32x32x16_bf16(Uc, Bq[q], acc[q], 0, 0, 0); }
    float bre[2][16], bim[2][16];
#pragma unroll
    for (int i = 0; i < 16; ++i) {
        const unsigned x0 = __builtin_bit_cast(unsigned, (float)acc[0][i]), x1 = __builtin_bit_cast(unsigned, (float)acc[1][i]);
        const unsigned y0 = __builtin_bit_cast(unsigned, (float)acc[2][i]), y1 = __builtin_bit_cast(unsigned, (float)acc[3][i]);
        const auto rr = __builtin_amdgcn_permlane32_swap(x0, x1, false, false);
        const auto ri = __builtin_amdgcn_permlane32_swap(y0, y1, false, false);
        bre[0][i] = __builtin_bit_cast(float, (unsigned)rr[0]); bre[1][i] = __builtin_bit_cast(float, (unsigned)rr[1]);
        bim[0][i] = __builtin_bit_cast(float, (unsigned)ri[0]); bim[1][i] = __builtin_bit_cast(float, (unsigned)ri[1]);
    }
    float cr = sre, ci = sim; const float nlbi = -lbi;
#pragma unroll
    for (int blk = 0; blk < 4; ++blk)
#pragma unroll
        for (int hh = 0; hh < 2; ++hh)
#pragma unroll
            for (int i2 = 0; i2 < 4; ++i2) {
                const int i = 4 * blk + i2, t = 8 * blk + 4 * hh + i2;
                float tr, ti, nre, nim;
                asm("v_fma_f32 %0, %1, %2, %3" : "=v"(tr) : "v"(nlbi), "v"(ci), "v"(bre[hh][i]));
                asm("v_fma_f32 %0, %1, %2, %3" : "=v"(ti) : "v"(lbi), "v"(cr), "v"(bim[hh][i]));
                asm("v_fma_f32 %0, %1, %2, %3" : "=v"(nre) : "v"(lbr), "v"(cr), "v"(tr));
                asm("v_fma_f32 %0, %1, %2, %3" : "=v"(nim) : "v"(lbr), "v"(ci), "v"(ti));
                cr = nre; ci = nim; pk[t] = cvt_pk_bf16(nre, nim);
            }
    sre = cr; sim = ci;
}
__device__ __forceinline__ void s5_readout(const LAS unsigned char* img, const bf16x8 (&Cq)[4], bf16_t* YS, int b, int d, int g, int c, int lane) {
#pragma unroll
    for (int tt = 0; tt < 2; ++tt) {
        const int tl = 16 * tt + (lane & 15);
        f32x4 o = (f32x4){0.f, 0.f, 0.f, 0.f};
#pragma unroll
        for (int ks = 0; ks < 4; ++ks) { const bf16x8 Sf = *(const LAS bf16x8*)(img + tl * 256 + (((4 * ks + (lane >> 4)) ^ (tl & 15)) << 4));
            o = __builtin_amdgcn_mfma_f32_16x16x32_bf16(Cq[ks], Sf, o, 0, 0, 0); }
        const int R = s5_row(b, d, c, tl);
        u32x2 w; w.x = cvt_pk_bf16(o[0], o[1]); w.y = cvt_pk_bf16(o[2], o[3]);
        *(u32x2*)(YS + ((size_t)d * MLAT + R) * D + 16 * g + 4 * (lane >> 4)) = w;
    }
}
__device__ __forceinline__ void s5_phase(ArgsP ap, Frame& F) {
    const bf16_t* H = (const bf16_t*)(ap->ws + WS_H);
    bf16_t* YS = (bf16_t*)(ap->ws + WS_HID);
    LAS unsigned char* my = F.lds + F.wave * 16384;
    const int gw = F.vcu * NWAVES + F.wave, NGW = F.G * NWAVES, lane = F.lane;
    for (int wu = gw; wu < BATCH * 2 * 128; wu += NGW) {
        const int g = wu & 127, d = (wu >> 7) & 1, b = wu >> 8, dg = d * 128 + g;
        const float dt = expf(ap->in[I_LSTEP][dg]);
        float lbr2[2], lbi2[2], fr2[2], fi2[2];
#pragma unroll
        for (int hh = 0; hh < 2; ++hh) { const int p = (lane & 31) + 32 * hh; s5_disc(ap->in[I_LRE][dg * 64 + p], ap->in[I_LIM][dg * 64 + p], dt, lbr2[hh], lbi2[hh], fr2[hh], fi2[hh]); }
        const float lbr = lane < 32 ? lbr2[0] : lbr2[1], lbi = lane < 32 ? lbi2[0] : lbi2[1];
        bf16x8 Bq[4];
#pragma unroll
        for (int hh = 0; hh < 2; ++hh) {
            const int p = (lane & 31) + 32 * hh; const float* bre = ap->in[I_BRE] + ((size_t)dg * 64 + p) * 16 + 8 * (lane >> 5); const float* bim = ap->in[I_BIM] + ((size_t)dg * 64 + p) * 16 + 8 * (lane >> 5);
            const f32x4 r0 = *(const f32x4*)bre, r1 = *(const f32x4*)(bre + 4), i0 = *(const f32x4*)bim, i1 = *(const f32x4*)(bim + 4);
            const float frr = fr2[hh], fii = fi2[hh];
            const f32x4 re0 = r0 * frr - i0 * fii, re1 = r1 * frr - i1 * fii, im0 = i0 * frr + r0 * fii, im1 = i1 * frr + r1 * fii;
            u32x4 wre, wim; wre.x = pk2(re0.x, re0.y); wre.y = pk2(re0.z, re0.w); wre.z = pk2(re1.x, re1.y); wre.w = pk2(re1.z, re1.w);
            wim.x = pk2(im0.x, im0.y); wim.y = pk2(im0.z, im0.w); wim.z = pk2(im1.x, im1.y); wim.w = pk2(im1.z, im1.w);
            Bq[hh] = __builtin_bit_cast(bf16x8, wre); Bq[2 + hh] = __builtin_bit_cast(bf16x8, wim);
        }
        bf16x8 Cq[4];
#pragma unroll
        for (int ks = 0; ks < 4; ++ks) { const int p0 = 16 * ks + 4 * (lane >> 4); const size_t off = ((size_t)dg * 16 + (lane & 15)) * 64 + p0;
            const f32x4 cr = *(const f32x4*)(ap->in[I_CRE] + off), ci = *(const f32x4*)(ap->in[I_CIM] + off);
            u32x4 w; w.x = pk2(cr.x, -ci.x); w.y = pk2(cr.y, -ci.y); w.z = pk2(cr.z, -ci.z); w.w = pk2(cr.w, -ci.w); Cq[ks] = __builtin_bit_cast(bf16x8, w); }
        float sre = 0.f, sim = 0.f;
#define row_of(c, m) s5_row(b, d, (c), (m))
        const int hoff = 16 * g + 8 * (lane >> 5);
        LAS unsigned char* ring = F.lds + S5RING_OFF + F.wave * 3072;
#define S5_DMA(c_) __builtin_amdgcn_global_load_lds((const unsigned*)(H + (size_t)row_of((c_), lane & 31) * D + hoff), (LAS unsigned*)(ring + ((c_) % 3) * 1024), 16, 0, 0)
#define S5_UFRAG(c_) (*(const LAS bf16x8*)(ring + ((c_) % 3) * 1024 + lane * 16))
        S5_DMA(0); S5_DMA(1); S5_DMA(2);
        unsigned pk[32];
        for (int c = 0; c < 8; ++c) {
            asm volatile("s_waitcnt vmcnt(2)" ::: "memory");
            const bf16x8 Uc = S5_UFRAG(c);
            s5_drive_scan(Uc, Bq, lbr, lbi, sre, sim, pk);
            S5_DMA(c + 3);
        }
        for (int c = 8; c < 137; ++c) {
            if (c > 8) s5_readout(my + ((c - 1) & 1) * 8192, Cq, YS, b, d, g, c - 1, lane);
            if (c < 136) {
                if (c >= 11 && c < 133) asm volatile("s_waitcnt vmcnt(6)" ::: "memory");
                else if (c < 11) asm volatile("s_waitcnt vmcnt(2)" ::: "memory");
                else asm volatile("s_waitcnt vmcnt(0)" ::: "memory");
                const bf16x8 Uc = S5_UFRAG(c);
                s5_drive_scan(Uc, Bq, lbr, lbi, sre, sim, pk);
                if (c + 3 < 136) S5_DMA(c + 3);
                LAS unsigned char* wb = my + (c & 1) * 8192;
#pragma unroll
                for (int t = 0; t < 32; ++t) *(LAS unsigned*)(wb + t * 256 + ((((lane >> 2) ^ (t & 15))) << 4) + (lane & 3) * 4) = pk[t];
            }
            asm volatile("s_waitcnt lgkmcnt(0)" ::: "memory");
        }
#undef S5_DMA
#undef S5_UFRAG
    }
}

#undef row_of
__device__ __forceinline__ float gelu_tanh(float x) { const float z = 0.7978845608028654f * (x + 0.044715f * x * x * x); return x * fast_sigmoid(2.0f * z); }
__device__ __forceinline__ void combine_phase(ArgsP ap, Frame& F) {
    bf16_t* H = (bf16_t*)(ap->ws + WS_H); const bf16_t* YS = (const bf16_t*)(ap->ws + WS_HID); const float* dv = ap->in[I_S5D];
    const size_t nvec = (size_t)MLAT * D / 8, stride = (size_t)F.G * NWAVES * 64;
    for (size_t i = (size_t)blockIdx.x * (NWAVES * 64) + F.tid; i < nvec; i += stride) {
        const int c0 = (int)((i * 8) & (D - 1));
        const u32x4 hw = *(const u32x4*)(H + i * 8), y0 = *(const u32x4*)(YS + i * 8), y1 = *(const u32x4*)(YS + (size_t)MLAT * D + i * 8);
        const f32x4 d0 = *(const f32x4*)(dv + c0), d1 = *(const f32x4*)(dv + c0 + 4);
        float v[8];
        v[0] = bflo(hw.x) * d0.x + bflo(y0.x) + bflo(y1.x); v[1] = bfhi(hw.x) * d0.y + bfhi(y0.x) + bfhi(y1.x);
        v[2] = bflo(hw.y) * d0.z + bflo(y0.y) + bflo(y1.y); v[3] = bfhi(hw.y) * d0.w + bfhi(y0.y) + bfhi(y1.y);
        v[4] = bflo(hw.z) * d1.x + bflo(y0.z) + bflo(y1.z); v[5] = bfhi(hw.z) * d1.y + bfhi(y0.z) + bfhi(y1.z);
        v[6] = bflo(hw.w) * d1.z + bflo(y0.w) + bflo(y1.w); v[7] = bfhi(hw.w) * d1.w + bfhi(y0.w) + bfhi(y1.w);
#pragma unroll
        for (int j = 0; j < 8; ++j) v[j] = gelu_tanh(v[j]);
        u32x4 o; o.x = pk2(v[0], v[1]); o.y = pk2(v[2], v[3]); o.z = pk2(v[4], v[5]); o.w = pk2(v[6], v[7]);
        *(u32x4*)(H + i * 8) = o;
    }
}

constexpr int N_PHASES = 22;
__device__ __forceinline__ Frame make_frame(LAS unsigned char* lds, int tid) {
    Frame F; F.lds = lds; F.tid = tid; F.lane = tid & 63; F.wave = __builtin_amdgcn_readfirstlane(tid >> 6);
    F.G = gridDim.x; { const int bx = blockIdx.x; F.vcu = (F.G % 8 == 0) ? (bx % 8) * (F.G / 8) + bx / 8 : bx; }
    return F;
}
__global__ void __launch_bounds__(NWAVES * 64, 2) fwd_kernel(Args args_unused) {
    extern __shared__ __attribute__((aligned(16))) unsigned char lds[];
    LAS unsigned char* const L = (LAS unsigned char*)lds;
    unsigned long long kp = (unsigned long long)__builtin_amdgcn_kernarg_segment_ptr();
    int tid0 = threadIdx.x;
    volatile LAS unsigned* MISC = (volatile LAS unsigned*)(L + MISC_OFF);
    for (int u = tid0; u < (LDS_BYTES - LDSCTL_OFF) / 4; u += NWAVES * 64) ((LAS unsigned*)(L + LDSCTL_OFF))[u] = 0u;
    __syncthreads();
    const int lo = ((ArgsP)kp)->ph_lo, hi = ((ArgsP)kp)->ph_hi;
    XcdBarrier bar; bar.bar = (unsigned*)(((ArgsP)kp)->ws + WS_CTL) + CW_BAR; bar.x = 0; bar.st = nullptr;
    if (hi - lo > 1) bar = xcd_barrier_post(bar.bar, MISC + 8);
    int ph = 0;
#define PH_ON (ph >= lo && ph < hi)
#define PH_BEGIN asm volatile("" : "+s"(kp)); int tid = tid0; asm volatile("" : "+v"(tid)); const ArgsP ap = (ArgsP)kp; Frame F = make_frame(L, tid); unsigned char* const ws = ap->ws; (void)ws; (void)F;
#define PH_END do { if (ph >= lo && ph + 1 < hi) xcd_barrier(bar); ++ph; } while (0)
#define WSP(T, off) ((T*)(ws + (off)))

    if (PH_ON) { PH_BEGIN; p0_prologue(ap, F); }
    PH_END;

    for (int s = 0; s < 4; ++s) {
        const int l = s >> 1, Ms = (s == 3) ? MLAT : MALL;
        if (PH_ON) {
            PH_BEGIN;
            const float* MOD = WSP(const float, WS_MOD); const float* NG = ap->in[I_NORMG]; void* X = WSP(void, WS_X16); void* XC = WSP(void, WS_XC);
            NormP p{};
            p.y = WSP(const bf16_t, WS_Y); p.h = WSP(bf16_t, WS_H); p.M = Ms; p.has_pre = 1;
            p.mod_pre = MOD + (size_t)l * 9 * NMODV; p.ipre = (s & 1) ? 2 : 0; p.g_pre = NG + (size_t)(l * 6 + 2 * p.ipre) * D;
            if (s == 0) { p.has_post = 0; p.src_lat = ap->in[I_X]; p.src_ctx = ap->in[I_CTX]; p.src_f32 = 1; p.dst_lat = X; p.dst_ctx = XC; p.mod_post = MOD; p.g_post = NG; p.ipost = 0; p.weight = 0.f; }
            else { const int lp = (s == 2) ? 0 : l, ip = (s == 2) ? 2 : 1;
                p.has_post = 1; p.src_lat = X; p.src_ctx = XC; p.dst_lat = X; p.dst_ctx = XC; p.mod_post = MOD + (size_t)lp * 9 * NMODV; p.ipost = ip; p.g_post = NG + (size_t)(lp * 6 + 2 * ip + 1) * D; p.weight = (ip == 1) ? 1.0f : 0.5f; }
            norm_phase(F, p);
        }
        PH_END;
        if (PH_ON) {
            PH_BEGIN;
            pg8::Gemm g{WSP(const bf16_t, WS_H), WSP(const bf16_t, WS_WGU) + (size_t)s * (2 * DFF) * D, Ms, 2 * DFF, D, D, D, 0};
            pg8::StaticOrder S; S.init(Ms, 2 * DFF, F.G, (int)blockIdx.x);
            pg8::EpiGated<0> E{WSP(bf16_t, WS_HID), DFF};
            pg8::gemm_phase<pg8::EpiGated<0>, pg8::StaticOrder, true, true>(L, g, S, E, tid);
        }
        PH_END;
        if (PH_ON) {
            PH_BEGIN;
            pg8::Gemm g{WSP(const bf16_t, WS_HID), WSP(const bf16_t, WS_WD) + (size_t)s * D * DFF, Ms, D, DFF, DFF, DFF, 0};
            pg8::StaticOrder S; S.init(Ms, D, F.G, (int)blockIdx.x, 4, 1, 1);
            pg8::EpiBf16 E{WSP(bf16_t, WS_Y), D, nullptr};
            pg8::gemm_phase<pg8::EpiBf16, pg8::StaticOrder, false, true>(L, g, S, E, tid);
            if (s < 3) {
                const int nu = (MALL / 256) * (D / 256), fi = nu % F.G;
                __syncthreads();
                if (s == 0) convert_in_tail(ap, F, fi, 3 * CV_FFN, 6 * CV_FFN, CV_MIX0, CV_MIX1);
                else if (s == 1) convert_in_tail(ap, F, fi, 6 * CV_FFN, 9 * CV_FFN, 0, 0);
                else convert_in_tail(ap, F, fi, 9 * CV_FFN, 12 * CV_FFN, CV_MIX1, CV_GLU1);
            }
        }
        PH_END;
        if (s == 0 || s == 2) {
            if (PH_ON) {
                PH_BEGIN;
                const float* MOD = WSP(const float, WS_MOD); const float* NG = ap->in[I_NORMG]; void* X = WSP(void, WS_X16); void* XC = WSP(void, WS_XC);
                NormP p{};
                p.y = WSP(const bf16_t, WS_Y); p.h = WSP(bf16_t, WS_H); p.M = MALL; p.has_pre = 1; p.has_post = 1;
                p.src_lat = (s == 0) ? (const void*)ap->in[I_X] : (const void*)X; p.src_ctx = (s == 0) ? (const void*)ap->in[I_CTX] : (const void*)XC; p.src_f32 = (s == 0); p.dst_lat = X; p.dst_ctx = XC;
                p.mod_post = MOD + (size_t)l * 9 * NMODV; p.ipost = 0; p.g_post = NG + (size_t)(l * 6 + 1) * D; p.weight = 0.5f;
                p.mod_pre = MOD + (size_t)l * 9 * NMODV; p.ipre = 1; p.g_pre = NG + (size_t)(l * 6 + 2) * D;
                norm_phase(F, p);
            }
            PH_END;
        }
        if (s == 0) {
            if (PH_ON) {
                PH_BEGIN;
                pg8::Gemm g{WSP(const bf16_t, WS_H), WSP(const bf16_t, WS_WIN), MALL, INCOLS, D, D, D, 0};
                pg8::StaticOrder S; S.init(MALL, INCOLS, F.G, (int)blockIdx.x);
                pg8::EpiInProj E{WSP(bf16_t, WS_HID), PCOLS};
                pg8::gemm_phase<pg8::EpiInProj, pg8::StaticOrder, true, true>(L, g, S, E, tid);
            }
            if (PH_ON) {
                PH_BEGIN;
                const int nui = (MALL / 256) * (INCOLS / 256), fii = nui % F.G;
                if ((int)blockIdx.x >= fii) {
                    pg8::Gemm g{WSP(const bf16_t, WS_TMP) + MIXA, WSP(const bf16_t, WS_PWT), D, 1024, 256, D, 256, 256};
                    pg8::StaticOrder S; S.init(D, 1024, F.G - fii, (int)blockIdx.x - fii);
                    pg8::EpiBf16 E{WSP(bf16_t, WS_WOUT) + MIXA, D, nullptr};
                    pg8::gemm_phase<pg8::EpiBf16, pg8::StaticOrder, true, true>(L, g, S, E, tid);
                }
            }
            PH_END;
            if (PH_ON) { PH_BEGIN; stencil_phase(ap, F); }
            PH_END;
            if (PH_ON) {
                PH_BEGIN;
                pg8::Gemm g{WSP(const bf16_t, WS_H), WSP(const bf16_t, WS_WOUT), MALL, D, D, D, D, 0};
                pg8::StaticOrder S; S.init(MALL, D, F.G, (int)blockIdx.x, 4, 0, 1);
                pg8::EpiBf16 E{WSP(bf16_t, WS_Y), D, nullptr};
                pg8::gemm_phase<pg8::EpiBf16, pg8::StaticOrder, true, true>(L, g, S, E, tid);
            }
            PH_END;
        }
        if (s == 2) {
            if (PH_ON) { PH_BEGIN; s5_phase(ap, F); }
            PH_END;
            if (PH_ON) { PH_BEGIN; combine_phase(ap, F); }
            PH_END;
            if (PH_ON) {
                PH_BEGIN;
                pg8::Gemm g{WSP(const bf16_t, WS_H), WSP(const bf16_t, WS_WAB), MLAT, 2 * D, D, D, D, 0};
                pg8::StaticOrder S; S.init(MLAT, 2 * D, F.G, (int)blockIdx.x);
                pg8::EpiGated<1> E{WSP(bf16_t, WS_Y), D};
                pg8::gemm_phase<pg8::EpiGated<1>, pg8::StaticOrder, true, true>(L, g, S, E, tid);
            }
            PH_END;
        }
    }
    if (PH_ON) {
        PH_BEGIN;
        const float* MOD = WSP(const float, WS_MOD); const float* NG = ap->in[I_NORMG]; void* X = WSP(void, WS_X16); void* XC = WSP(void, WS_XC);
        NormP p{};
        p.y = WSP(const bf16_t, WS_Y); p.h = WSP(bf16_t, WS_H); p.M = MLAT; p.has_pre = 0; p.has_post = 1;
        p.src_lat = X; p.src_ctx = XC; p.dst_lat = ap->out; p.dst_ctx = XC; p.dst_f32 = 1;
        p.mod_post = MOD + (size_t)9 * NMODV; p.ipost = 2; p.g_post = NG + (size_t)(6 + 5) * D; p.weight = 0.5f;
        p.mod_pre = MOD; p.ipre = 0; p.g_pre = NG;
        norm_phase(F, p);
    }
    PH_END;
#undef PH_ON
#undef PH_BEGIN
#undef PH_END
#undef WSP
}

extern "C" void kernel_launch(void* const* d_in, const int* in_sizes, int n_in, void* d_out, int out_size, void* d_ws, size_t ws_size, hipStream_t stream) {
    static int grid = 0;
    if (grid == 0) {
        if (n_in != N_IN || in_sizes[0] != MLAT * D || out_size != MLAT * D || ws_size < WS_END) {
            fprintf(stderr, "kernel_launch: unexpected shapes (n_in %d, in0 %d, out %d, ws %zu); nothing launched\n", n_in, n_in > 0 ? in_sizes[0] : -1, out_size, ws_size); grid = -1; return; }
        int dev = 0, cus = 0, per_cu = 0;
        if (hipGetDevice(&dev) != hipSuccess || hipDeviceGetAttribute(&cus, hipDeviceAttributeMultiprocessorCount, dev) != hipSuccess) { fprintf(stderr, "kernel_launch: device query failed\n"); grid = -1; return; }
        if (hipFuncSetAttribute((const void*)fwd_kernel, hipFuncAttributeMaxDynamicSharedMemorySize, LDS_BYTES) != hipSuccess) { fprintf(stderr, "kernel_launch: hipFuncSetAttribute failed\n"); grid = -1; return; }
        if (hipOccupancyMaxActiveBlocksPerMultiprocessor(&per_cu, (const void*)fwd_kernel, NWAVES * 64, LDS_BYTES) != hipSuccess || per_cu < 1) {
            fprintf(stderr, "kernel_launch: occupancy query reports %d workgroups per CU; nothing launched\n", per_cu); (void)hipGetLastError(); grid = -1; return; }
        grid = cus;
    }
    if (grid < 0) return;
    if (hipMemsetAsync((char*)d_ws + WS_CTL, 0, CTL_ZERO_BYTES, stream) != hipSuccess) { fprintf(stderr, "kernel_launch: memset failed\n"); return; }
    Args a{};
    for (int i = 0; i < N_IN; ++i) a.in[i] = (const float*)d_in[i];
    a.out = (float*)d_out; a.ws = (unsigned char*)d_ws; a.li = 0; a.pad = 0;
#if MK_PER_PHASE
    for (int k = 0; k < N_PHASES; ++k) { a.ph_lo = k; a.ph_hi = k + 1; hipLaunchKernelGGL(fwd_kernel, dim3(grid), dim3(NWAVES * 64), LDS_BYTES, stream, a); }
#else
    a.ph_lo = 0; a.ph_hi = N_PHASES;
    hipLaunchKernelGGL(fwd_kernel, dim3(grid), dim3(NWAVES * 64), LDS_BYTES, stream, a);
#endif
    const hipError_t le = hipPeekAtLastError();
    if (le != hipSuccess) fprintf(stderr, "kernel_launch: launch failed: %s\n", hipGetErrorName(le));
}
```

```cpp
#include <hip/hip_runtime.h>
#include <stdio.h>

#ifndef MK_PER_PHASE
#define MK_PER_PHASE 0
#endif

#define LAS __attribute__((address_space(3)))
#define GAS __attribute__((address_space(1)))
typedef unsigned short bf16_t;
typedef short bf16x8 __attribute__((ext_vector_type(8)));
typedef float f32x4 __attribute__((ext_vector_type(4)));
typedef float f32x2 __attribute__((ext_vector_type(2)));
typedef float f32x16 __attribute__((ext_vector_type(16)));
typedef unsigned u32x4 __attribute__((ext_vector_type(4)));
typedef unsigned u32x2 __attribute__((ext_vector_type(2)));
typedef GAS unsigned gu32;
typedef _Float16 f16x4 __attribute__((ext_vector_type(4)));

constexpr int D = 2048, BATCH = 8, SEQ = 4096, CTXL = 256, DFF = 5632, NMODV = 9 * D;
constexpr int MLAT = BATCH * SEQ, MCTX = BATCH * CTXL, MALL = MLAT + MCTX;
constexpr int MIXA = 1024, INCOLS = 4096, PCOLS = 3072;
constexpr float EPS = 1e-6f;
enum { I_X = 0, I_C, I_CTX, I_CCTX, I_WMOD, I_BMOD, I_NORMG, I_WG, I_WU, I_WD, I_MIXIN, I_CONVW, I_POOLW, I_POOLS, I_MIXOUT,
       I_LRE, I_LIM, I_LSTEP, I_BRE, I_BIM, I_CRE, I_CIM, I_S5D, I_GLUA, I_GLUB, N_IN };

constexpr size_t MiB = 1u << 20;
constexpr size_t WS_CTL = 0, CTL_ZERO_BYTES = 1 * MiB;
constexpr size_t WS_MOD = 2 * MiB;
constexpr size_t WS_PWT = 4 * MiB;
constexpr size_t WS_WIN = 8 * MiB;
constexpr size_t WS_WOUT = 24 * MiB;
constexpr size_t WS_WAB = 32 * MiB;
constexpr size_t WS_WGU = 48 * MiB;
constexpr size_t WS_WD = 224 * MiB;
constexpr size_t WS_XC = 312 * MiB;
constexpr size_t WS_TMP = 320 * MiB;
constexpr size_t WS_H = 328 * MiB;
constexpr size_t WS_Y = 464 * MiB;
constexpr size_t WS_HID = 600 * MiB;
constexpr size_t WS_X16 = 974 * MiB;
constexpr size_t WS_END = 1102 * MiB;
constexpr int CW_BAR = 4096;

constexpr int RING_BYTES = 131072;
constexpr int LDSCTL_OFF = RING_BYTES, MISC_OFF = LDSCTL_OFF + 320;
constexpr int LDS_BYTES = 163840;
constexpr int S5RING_OFF = 135168;
constexpr int NWAVES = 8;

typedef __bf16 bf16x2_t __attribute__((ext_vector_type(2)));
__device__ __forceinline__ unsigned cvt_pk_bf16(float lo, float hi) { const f32x2 v = {lo, hi}; return __builtin_bit_cast(unsigned, __builtin_convertvector(v, bf16x2_t)); }
__device__ __forceinline__ unsigned pk2(float lo, float hi) { return cvt_pk_bf16(lo, hi); }
__device__ __forceinline__ float bflo(unsigned w) { return __builtin_bit_cast(float, w << 16); }
__device__ __forceinline__ float bfhi(unsigned w) { return __builtin_bit_cast(float, w & 0xffff0000u); }
#define DPP_ADD_(v, ctrl) v += __builtin_bit_cast(float, __builtin_amdgcn_update_dpp(0, __builtin_bit_cast(int, v), ctrl, 0xF, 0xF, true))
__device__ __forceinline__ float wave_sum(float v) {
    DPP_ADD_(v, 0xB1); DPP_ADD_(v, 0x4E); DPP_ADD_(v, 0x141); DPP_ADD_(v, 0x140);
    const int iv = __builtin_bit_cast(int, v);
    return (__builtin_bit_cast(float, __builtin_amdgcn_readlane(iv, 0)) + __builtin_bit_cast(float, __builtin_amdgcn_readlane(iv, 16))) +
           (__builtin_bit_cast(float, __builtin_amdgcn_readlane(iv, 32)) + __builtin_bit_cast(float, __builtin_amdgcn_readlane(iv, 48)));
}
__device__ __forceinline__ float fast_sigmoid(float x) { return __builtin_amdgcn_rcpf(1.0f + __expf(-x)); }
#define LDS_WAIT() asm volatile("s_waitcnt lgkmcnt(0)" ::: "memory")
#define VM_WAIT() asm volatile("s_waitcnt vmcnt(0)" ::: "memory")
#define RLX_AGENT __ATOMIC_RELAXED, __HIP_MEMORY_SCOPE_AGENT

namespace pg8 {
#define PG8_LAS __attribute__((address_space(3)))
constexpr int BM = 256, BK = 64, HALF = 128, HTB = HALF * BK * 2, STAGE_BYTES = 8 * HTB, NXCD = 8, WGM = 8;
__host__ __device__ __forceinline__ int lds_byte(int r, int c) { const int st = (r >> 4) * 2 + (c >> 5), rr = r & 15, cc = c & 31, ob = rr * 64 + cc * 2; return st * 1024 + (ob ^ (((ob >> 9) & 1) << 5)); }
__host__ __device__ __forceinline__ void stage_rc(int b, int& R, int& C) { const int st = b / 1024, sb = b % 1024, swz = sb ^ (((sb >> 9) & 1) << 5); R = (st >> 1) * 16 + swz / 64; C = (st & 1) * 32 + (swz % 64) / 2; }
__host__ __device__ __forceinline__ int perm32(int rho) { const int n = rho >> 4, i = rho & 15; return 8 * (i >> 2) + 4 * n + (i & 3); }

struct Unit { int pm, pn; };
struct Gemm { const bf16_t* A; const bf16_t* Bt; int M, N, K, lda, ldb, a_pn_off; };

struct StaticOrder {
    int nM, nN, nwg, G, c, wgm, rev, xloc;
    __host__ __device__ void init(int M, int N, int G_, int c_, int wgm_ = WGM, int rev_ = 0, int xloc_ = 0) {
        nM = M / BM; nN = N / BM; nwg = nM * nN; G = G_; c = c_; wgm = wgm_; rev = rev_; xloc = (xloc_ && nM % NXCD == 0 && G_ % NXCD == 0) ? 1 : 0; }
    __host__ __device__ bool next(int i, Unit& u) const {
        const long L = (long)i * G + c; if (L >= nwg) return false;
        if (xloc) {
            const int xcd = (int)L % NXCD, off = (int)L / NXCD, pmx = nM / NXCD, nig = wgm * nN, gid = off / nig, fm = gid * wgm, gsz = (pmx - fm) < wgm ? (pmx - fm) : wgm, idx = off - gid * nig;
            u.pm = xcd * pmx + fm + idx % gsz; u.pn = idx / gsz;
        } else {
            int wgid = (int)L; { const int q = nwg / NXCD, r = nwg % NXCD, xcd = wgid % NXCD, off = wgid / NXCD; wgid = (xcd < r ? xcd * (q + 1) : r * (q + 1) + (xcd - r) * q) + off; }
            const int nig = wgm * nN, gid = wgid / nig, fm = gid * wgm, gsz = (nM - fm) < wgm ? (nM - fm) : wgm;
            u.pm = fm + ((wgid % nig) % gsz); u.pn = (wgid % nig) / gsz;
        }
        if (rev) u.pm = nM - 1 - u.pm; return true;
    }
    __device__ __forceinline__ void a_ready(const Unit&) const {}
    __device__ __forceinline__ void done(const Unit&) const {}
};

struct EpiBf16 {
    static constexpr bool PERM = true, AFTER_DRAIN = false;
    bf16_t* O; int ldc; const float* colscale;
    __device__ __forceinline__ void operator()(const f32x4 (&acc)[2][2][4][2], const Unit& u, int wr, int wc, int fr, int fq) const {
        const int row0 = u.pm * BM + wr * 64 + fr, col0 = u.pn * BM + wc * 32 + 8 * fq;
        f32x4 sv[2][2];
#pragma unroll
        for (int bj = 0; bj < 2; ++bj)
#pragma unroll
            for (int n = 0; n < 2; ++n) sv[bj][n] = colscale ? *(const f32x4*)(colscale + col0 + bj * HALF + 4 * n) : (f32x4){1.f, 1.f, 1.f, 1.f};
#pragma unroll
        for (int ai = 0; ai < 2; ++ai)
#pragma unroll
            for (int m = 0; m < 4; ++m) { bf16_t* rowp = O + (size_t)(row0 + ai * HALF + m * 16) * ldc + col0;
#pragma unroll
                for (int bj = 0; bj < 2; ++bj) { const f32x4 v0 = acc[ai][bj][m][0] * sv[bj][0], v1 = acc[ai][bj][m][1] * sv[bj][1];
                    u32x4 w; w.x = cvt_pk_bf16(v0[0], v0[1]); w.y = cvt_pk_bf16(v0[2], v0[3]); w.z = cvt_pk_bf16(v1[0], v1[1]); w.w = cvt_pk_bf16(v1[2], v1[3]);
                    *(u32x4*)(rowp + bj * HALF) = w; } }
    }
};
struct EpiInProj {
    static constexpr bool PERM = true, AFTER_DRAIN = false;
    bf16_t* O; int ldc;
    __device__ __forceinline__ void operator()(const f32x4 (&acc)[2][2][4][2], const Unit& u, int wr, int wc, int fr, int fq) const {
        const int row0 = u.pm * BM + wr * 64 + fr;
        if (u.pn >= 4 && u.pn < 12) {
            const int col0 = 1024 + (u.pn - 4) * HALF + wc * 32 + 8 * fq;
#pragma unroll
            for (int ai = 0; ai < 2; ++ai)
#pragma unroll
                for (int m = 0; m < 4; ++m) { bf16_t* rowp = O + (size_t)(row0 + ai * HALF + m * 16) * ldc + col0;
                    const f32x4 p0 = acc[ai][0][m][0] * acc[ai][1][m][0], p1 = acc[ai][0][m][1] * acc[ai][1][m][1];
                    u32x4 w; w.x = cvt_pk_bf16(p0[0], p0[1]); w.y = cvt_pk_bf16(p0[2], p0[3]); w.z = cvt_pk_bf16(p1[0], p1[1]); w.w = cvt_pk_bf16(p1[2], p1[3]);
                    *(u32x4*)rowp = w; }
        } else {
            const int col0 = (u.pn < 4 ? u.pn * BM : 2048 + (u.pn - 12) * BM) + wc * 32 + 8 * fq;
#pragma unroll
            for (int ai = 0; ai < 2; ++ai)
#pragma unroll
                for (int m = 0; m < 4; ++m) { bf16_t* rowp = O + (size_t)(row0 + ai * HALF + m * 16) * ldc + col0;
#pragma unroll
                    for (int bj = 0; bj < 2; ++bj) { const f32x4 v0 = acc[ai][bj][m][0], v1 = acc[ai][bj][m][1];
                        u32x4 w; w.x = cvt_pk_bf16(v0[0], v0[1]); w.y = cvt_pk_bf16(v0[2], v0[3]); w.z = cvt_pk_bf16(v1[0], v1[1]); w.w = cvt_pk_bf16(v1[2], v1[3]);
                        *(u32x4*)(rowp + bj * HALF) = w; } }
        }
    }
};
template <int MODE> struct EpiGated {
    static constexpr bool PERM = true, AFTER_DRAIN = false;
    bf16_t* O; int ldc;
    __device__ __forceinline__ void operator()(const f32x4 (&acc)[2][2][4][2], const Unit& u, int wr, int wc, int fr, int fq) const {
        const int row0 = u.pm * BM + wr * 64 + fr, col0 = u.pn * HALF + wc * 32 + 8 * fq;
#pragma unroll
        for (int ai = 0; ai < 2; ++ai)
#pragma unroll
            for (int m = 0; m < 4; ++m) { bf16_t* rowp = O + (size_t)(row0 + ai * HALF + m * 16) * ldc + col0;
                float o[8];
#pragma unroll
                for (int n = 0; n < 2; ++n)
#pragma unroll
                    for (int j = 0; j < 4; ++j) { const float a = acc[ai][0][m][n][j], b = acc[ai][1][m][n][j];
                        o[4 * n + j] = (MODE == 0) ? (a * fast_sigmoid(a)) * b : a * fast_sigmoid(b); }
                u32x4 w; w.x = cvt_pk_bf16(o[0], o[1]); w.y = cvt_pk_bf16(o[2], o[3]); w.z = cvt_pk_bf16(o[4], o[5]); w.w = cvt_pk_bf16(o[6], o[7]);
                *(u32x4*)rowp = w; }
    }
};

template <class Epi, class Sched, bool ALIGN_EPI = false, bool SP2 = false>
__device__ __forceinline__ void gemm_phase(PG8_LAS unsigned char* lds, const Gemm g, const Sched& S, const Epi& E, const int tid) {
    const int wid = __builtin_amdgcn_readfirstlane(tid >> 6), lane = tid & 63, wr = wid >> 2, wc = wid & 3, fr = lane & 15, fq = lane >> 4;
    const int K = g.K, nt = K / BK;
    unsigned voffA[2], voffB[2];
#pragma unroll
    for (int i = 0; i < 2; ++i) { int R, C; stage_rc(tid * 16 + i * 8192, R, C); const int Rb = Epi::PERM ? ((R & ~31) + perm32(R & 31)) : R;
        voffA[i] = (unsigned)(R * g.lda + C) * 2u; voffB[i] = (unsigned)(Rb * g.ldb + C) * 2u; }
    const size_t kstep = (size_t)(BK * 2);
    const size_t hstepA = (size_t)HALF * g.lda * 2, hstepB = (size_t)HALF * g.ldb * 2;
    const size_t tstepA = 2 * hstepA, tstepB = 2 * hstepB;
    const size_t pnA = (size_t)g.a_pn_off * 2;
    const unsigned ldsw = (unsigned)wid * 1024u;
    const int aoff = lds_byte(wr * 64 + fr, fq * 8), boff = lds_byte(wc * 32 + fr, fq * 8);
#define PG8_SA(b, h) (((b) * 2 + (h)) * HTB)
#define PG8_SB(b, h) ((4 + (b) * 2 + (h)) * HTB)
#define PG8_STAGE(bufoff, gbase, voff) do { _Pragma("unroll") for (int _i = 0; _i < 2; ++_i) \
        __builtin_amdgcn_global_load_lds((const unsigned*)((const char*)(gbase) + (voff)[_i]), (PG8_LAS unsigned*)(lds + (bufoff) + ldsw + _i * 8192), 16, 0, 0); } while (0)
#define PG8_LDA(dst, b, h) do { _Pragma("unroll") for (int m = 0; m < 4; ++m) _Pragma("unroll") for (int k = 0; k < 2; ++k) dst[m][k] = *(const PG8_LAS bf16x8*)(lds + PG8_SA(b, h) + aoff + m * 2048 + k * 1024); } while (0)
#define PG8_LDB(dst, b, h) do { _Pragma("unroll") for (int n = 0; n < 2; ++n) _Pragma("unroll") for (int k = 0; k < 2; ++k) dst[n][k] = *(const PG8_LAS bf16x8*)(lds + PG8_SB(b, h) + boff + n * 2048 + k * 1024); } while (0)
#define PG8_MMA(ai, bj, At, Bt) do { __builtin_amdgcn_s_setprio(1); _Pragma("unroll") for (int m = 0; m < 4; ++m) _Pragma("unroll") for (int n = 0; n < 2; ++n) _Pragma("unroll") for (int k = 0; k < 2; ++k) \
        acc[ai][bj][m][n] = __builtin_amdgcn_mfma_f32_16x16x32_bf16(Bt[n][k], At[m][k], acc[ai][bj][m][n], 0, 0, 0); __builtin_amdgcn_s_setprio(0); } while (0)
#define PG8_WAIT_V(n) asm volatile("s_waitcnt vmcnt(" #n ")" ::: "memory")
#define PG8_WAIT_L(n) asm volatile("s_waitcnt lgkmcnt(" #n ")" ::: "memory")
#define PG8_BAR __builtin_amdgcn_s_barrier()
#define PG8_SCHED __builtin_amdgcn_sched_barrier(0)
    Unit cur, nxt; int ui = 0;
    if (!S.next(0, cur)) return;
    f32x4 acc[2][2][4][2];
#pragma unroll
    for (int a = 0; a < 2; ++a)
#pragma unroll
        for (int b = 0; b < 2; ++b)
#pragma unroll
            for (int m = 0; m < 4; ++m)
#pragma unroll
                for (int n = 0; n < 2; ++n) acc[a][b][m][n] = (f32x4){0.f, 0.f, 0.f, 0.f};
    bf16x8 At[4][2], B0[2][2], B1[2][2];
    const char* cA = (const char*)g.A + (size_t)cur.pm * tstepA + (size_t)cur.pn * pnA; const char* cB = (const char*)g.Bt + (size_t)cur.pn * tstepB;
    S.a_ready(cur);
    if constexpr (SP2) {
        PG8_STAGE(PG8_SB(0, 0), cB, voffB); PG8_STAGE(PG8_SB(0, 1), cB + hstepB, voffB); PG8_STAGE(PG8_SA(0, 0), cA, voffA); PG8_STAGE(PG8_SA(0, 1), cA + hstepA, voffA);
        if (wr == 1) PG8_BAR;
        PG8_WAIT_V(2); PG8_BAR;
        PG8_STAGE(PG8_SB(1, 0), cB + kstep, voffB); PG8_STAGE(PG8_SA(1, 0), cA + kstep, voffA); PG8_STAGE(PG8_SB(1, 1), cB + hstepB + kstep, voffB);
        PG8_WAIT_V(6); PG8_BAR;
    } else {
        PG8_STAGE(PG8_SB(0, 0), cB, voffB); PG8_STAGE(PG8_SA(0, 0), cA, voffA); PG8_STAGE(PG8_SB(0, 1), cB + hstepB, voffB); PG8_STAGE(PG8_SA(0, 1), cA + hstepA, voffA);
        if (wr == 1) PG8_BAR;
        PG8_WAIT_V(4); PG8_BAR;
        PG8_STAGE(PG8_SB(1, 0), cB + kstep, voffB); PG8_STAGE(PG8_SA(1, 0), cA + kstep, voffA); PG8_STAGE(PG8_SB(1, 1), cB + hstepB + kstep, voffB);
        PG8_WAIT_V(6); PG8_BAR;
    }
    for (;;) {
        const bool has_next = S.next(ui + 1, nxt);
        const char* nA = has_next ? (const char*)g.A + (size_t)nxt.pm * tstepA + (size_t)nxt.pn * pnA : cA; const char* nB = has_next ? (const char*)g.Bt + (size_t)nxt.pn * tstepB : cB;
        for (int t = 0; t < nt; t += 2) {
            const bool last = (t == nt - 2);
            const char* a1 = cA + (size_t)(t + 1) * kstep;
            const char* a2 = last ? nA : cA + (size_t)(t + 2) * kstep; const char* b2 = last ? nB : cB + (size_t)(t + 2) * kstep;
            const char* a3 = a2 + kstep; const char* b3 = b2 + kstep;
            if (last && has_next) S.a_ready(nxt);
            if constexpr (SP2) {
            PG8_LDB(B0, 0, 0); PG8_LDB(B1, 0, 1); PG8_SCHED; PG8_LDA(At, 0, 0); PG8_STAGE(PG8_SA(1, 1), a1 + hstepA, voffA);
            PG8_WAIT_V(8); PG8_WAIT_L(0); PG8_BAR; PG8_MMA(0, 0, At, B0); PG8_MMA(0, 1, At, B1); PG8_BAR; PG8_SCHED;
            PG8_LDA(At, 0, 1); PG8_STAGE(PG8_SB(0, 0), b2, voffB); PG8_STAGE(PG8_SB(0, 1), b2 + hstepB, voffB); PG8_STAGE(PG8_SA(0, 0), a2, voffA);
            PG8_WAIT_V(8); PG8_WAIT_L(0); PG8_BAR; PG8_MMA(1, 0, At, B0); PG8_MMA(1, 1, At, B1); PG8_BAR; PG8_SCHED;
            PG8_LDB(B0, 1, 0); PG8_LDB(B1, 1, 1); PG8_SCHED; PG8_LDA(At, 1, 0); PG8_STAGE(PG8_SA(0, 1), a2 + hstepA, voffA);
            PG8_WAIT_V(8); PG8_WAIT_L(0); PG8_BAR; PG8_MMA(0, 0, At, B0); PG8_MMA(0, 1, At, B1); PG8_BAR; PG8_SCHED;
            PG8_LDA(At, 1, 1); PG8_STAGE(PG8_SB(1, 0), b3, voffB); PG8_STAGE(PG8_SB(1, 1), b3 + hstepB, voffB); PG8_STAGE(PG8_SA(1, 0), a3, voffA);
            PG8_WAIT_V(8); PG8_WAIT_L(0); PG8_BAR; PG8_MMA(1, 0, At, B0); PG8_MMA(1, 1, At, B1); PG8_BAR; PG8_SCHED;
            } else {
            PG8_LDB(B0, 0, 0); PG8_SCHED; PG8_LDA(At, 0, 0); PG8_STAGE(PG8_SA(1, 1), a1 + hstepA, voffA);
            PG8_WAIT_L(8); PG8_BAR; PG8_WAIT_L(0); PG8_MMA(0, 0, At, B0); PG8_BAR; PG8_SCHED;
            PG8_LDB(B1, 0, 1); PG8_STAGE(PG8_SB(0, 0), b2, voffB);
            PG8_BAR; PG8_WAIT_L(0); PG8_MMA(0, 1, At, B1); PG8_BAR;
            PG8_LDA(At, 0, 1); PG8_STAGE(PG8_SA(0, 0), a2, voffA);
            PG8_BAR; PG8_WAIT_L(0); PG8_MMA(1, 0, At, B0); PG8_BAR; PG8_SCHED;
            PG8_STAGE(PG8_SB(0, 1), b2 + hstepB, voffB);
            PG8_WAIT_V(6); PG8_BAR; PG8_MMA(1, 1, At, B1); PG8_BAR;
            PG8_LDB(B0, 1, 0); PG8_SCHED; PG8_LDA(At, 1, 0); PG8_STAGE(PG8_SA(0, 1), a2 + hstepA, voffA);
            PG8_WAIT_L(8); PG8_BAR; PG8_WAIT_L(0); PG8_MMA(0, 0, At, B0); PG8_BAR; PG8_SCHED;
            PG8_LDB(B1, 1, 1); PG8_STAGE(PG8_SB(1, 0), b3, voffB);
            PG8_BAR; PG8_WAIT_L(0); PG8_MMA(0, 1, At, B1); PG8_BAR;
            PG8_LDA(At, 1, 1); PG8_STAGE(PG8_SA(1, 0), a3, voffA);
            PG8_BAR; PG8_WAIT_L(0); PG8_MMA(1, 0, At, B0); PG8_BAR; PG8_SCHED;
            PG8_STAGE(PG8_SB(1, 1), b3 + hstepB, voffB);
            PG8_WAIT_V(6); PG8_BAR; PG8_MMA(1, 1, At, B1); PG8_BAR;
            }
        }
        if constexpr (ALIGN_EPI) { if (wr == 0) PG8_BAR; }
        if constexpr (!Epi::AFTER_DRAIN) { E(acc, cur, wr, wc, fr, fq); S.done(cur); }
        if (!has_next) break;
#pragma unroll
        for (int a = 0; a < 2; ++a)
#pragma unroll
            for (int b = 0; b < 2; ++b)
#pragma unroll
                for (int m = 0; m < 4; ++m)
#pragma unroll
                    for (int n = 0; n < 2; ++n) acc[a][b][m][n] = (f32x4){0.f, 0.f, 0.f, 0.f};
        cur = nxt; cA = nA; cB = nB; ++ui;
        if constexpr (ALIGN_EPI) { if (wr == 1) PG8_BAR; }
    }
    PG8_WAIT_V(0);
    if constexpr (!ALIGN_EPI) { if (wr == 0) PG8_BAR; }
    PG8_BAR;
#undef PG8_SA
#undef PG8_SB
#undef PG8_STAGE
#undef PG8_LDA
#undef PG8_LDB
#undef PG8_MMA
#undef PG8_WAIT_V
#undef PG8_WAIT_L
#undef PG8_BAR
#undef PG8_SCHED
}
}

#define XB_TMO      128
#define XB_XCNT(j)  (256  + 64 * (j))
#define XB_XSUB(j)  (1280 + 64 * (j))
#define XB_XGEN(j)  (2304 + 64 * (j))
#define XB_TOP      3328
#define XB_TOPGEN   3392
#define XCD_BAR_WORDS 3456
#define XB_SPIN_CAP (1u << 18)

__device__ __forceinline__ unsigned xb_ld(unsigned* p)              { return __hip_atomic_load(p, __ATOMIC_RELAXED, __HIP_MEMORY_SCOPE_AGENT); }
__device__ __forceinline__ unsigned xb_add(unsigned* p, unsigned v) { return __hip_atomic_fetch_add(p, v, __ATOMIC_RELAXED, __HIP_MEMORY_SCOPE_AGENT); }
__device__ __forceinline__ unsigned xb_xcc_id() { return (unsigned)__builtin_amdgcn_s_getreg((3 << 11) | 20) & 0xFu; }
#define XB_SPIN(cond, bar) do { unsigned _sp = 0; while (cond) { __builtin_amdgcn_s_sleep(1); \
    if ((++_sp & 255u) == 0u) { if (xb_ld(&(bar)[XB_TMO])) break; if (_sp > XB_SPIN_CAP) { atomicAdd(&(bar)[XB_TMO], 1u); break; } } } } while (0)

struct XcdBarrier { unsigned* bar; unsigned x; volatile LAS unsigned* st; };

__device__ __forceinline__ XcdBarrier xcd_barrier_post(unsigned* bar, volatile LAS unsigned* st) {
    XcdBarrier b; b.bar = bar; b.x = xb_xcc_id(); b.st = st;
    if (threadIdx.x == 0) (void)xb_add(&bar[XB_XCNT(b.x)], 1u);
    return b;
}
__device__ __forceinline__ void xcd_barrier_complete(unsigned* bar, unsigned x, unsigned& nloc, unsigned& nx) {
    const unsigned G = gridDim.x * gridDim.y * gridDim.z;
    unsigned sum, cnt, mine, sp = 0u;
    for (;;) {
        sum = 0u; cnt = 0u; mine = 0u;
#pragma unroll
        for (unsigned j = 0; j < 16; ++j) { const unsigned c = xb_ld(&bar[XB_XCNT(j)]); sum += c; cnt += (c > 0u) ? 1u : 0u; mine = (j == x) ? c : mine; }
        if (sum == G) break;
        __builtin_amdgcn_s_sleep(1);
        if ((++sp & 255u) == 0u) { if (xb_ld(&bar[XB_TMO])) break; if (sp > XB_SPIN_CAP) { atomicAdd(&bar[XB_TMO], 1u); break; } }
    }
    nloc = mine > 0u ? mine : 1u; nx = cnt > 0u ? cnt : 1u;
}
__device__ __forceinline__ void xcd_barrier(const XcdBarrier& b) {
    asm volatile("s_waitcnt vmcnt(0)" ::: "memory");
    __syncthreads();
    if (threadIdx.x == 0) {
        unsigned* bar = b.bar;
        __builtin_amdgcn_s_waitcnt(0);
        unsigned nloc = b.st[0], nx = b.st[1];
        if (nloc == 0u) { xcd_barrier_complete(bar, b.x, nloc, nx); b.st[0] = nloc; b.st[1] = nx; }
        const unsigned old = xb_add(&bar[XB_XSUB(b.x)], 1u);
        const unsigned gen = old / nloc;
        if (old + 1u == (gen + 1u) * nloc) {
            __builtin_amdgcn_fence(__ATOMIC_RELEASE, "agent");
            asm volatile("s_waitcnt vmcnt(0)" ::: "memory");
            const unsigned og = xb_add(&bar[XB_TOP], 1u);
            const unsigned tg = og / nx;
            if (og + 1u == (tg + 1u) * nx) xb_add(&bar[XB_TOPGEN], 1u);
            else XB_SPIN(xb_ld(&bar[XB_TOPGEN]) == tg, bar);
            __builtin_amdgcn_fence(__ATOMIC_ACQUIRE, "agent");
            xb_add(&bar[XB_XGEN(b.x)], 1u);
            asm volatile("s_waitcnt vmcnt(0)" ::: "memory");
        } else {
            XB_SPIN(xb_ld(&bar[XB_XGEN(b.x)]) == gen, bar);
            __builtin_amdgcn_fence(__ATOMIC_ACQUIRE, "agent");
            asm volatile("s_waitcnt vmcnt(0)" ::: "memory");
        }
    }
    __syncthreads();
}

struct Args { const float* in[N_IN]; float* out; unsigned char* ws; int ph_lo, ph_hi, li, pad; };
struct Frame { LAS unsigned char* lds; int tid, lane, wave, vcu, G; };
typedef const __attribute__((address_space(4))) Args* ArgsP;


__device__ __forceinline__ void p0_transpose_item(const float* W, int N, bf16_t* WT, int Kdst, int k0, int n0, int drow0, LAS float* scr, int lane) {
#pragma unroll
    for (int i = 0; i < 32; ++i) { const int kk = 2 * i + (lane >> 5); scr[kk * 33 + (lane & 31)] = W[(size_t)(k0 + kk) * N + n0 + (lane & 31)]; }
    LDS_WAIT(); asm volatile("" ::: "memory");
    const int c = lane & 7;
#pragma unroll
    for (int j = 0; j < 4; ++j) { const int n = (lane >> 3) + 8 * j; const LAS float* s = scr + (8 * c) * 33 + n;
        u32x4 o; o.x = pk2(s[0 * 33], s[1 * 33]); o.y = pk2(s[2 * 33], s[3 * 33]); o.z = pk2(s[4 * 33], s[5 * 33]); o.w = pk2(s[6 * 33], s[7 * 33]);
        *(GAS u32x4*)(WT + (size_t)(drow0 + n) * Kdst + k0 + 8 * c) = o; }
    LDS_WAIT(); asm volatile("" ::: "memory");
}
__device__ __forceinline__ int ilv_row(int n, int hi) { return 256 * (n >> 7) + (n & 127) + 128 * hi; }

constexpr int CV_FFN = 5632, CV_FFN_ALL = 12 * CV_FFN, CV_MIX0 = CV_FFN_ALL, CV_MIX1 = CV_MIX0 + 4096 + 2048 + 128, CV_GLU1 = CV_MIX1 + 4096;
__device__ __forceinline__ void convert_items(ArgsP ap, int lo, int hi, int wrank, int nw, LAS float* scr, int lane) {
    unsigned char* ws = ap->ws;
    for (int it = lo + wrank; it < hi; it += nw) {
        int r = it;
        if (r < CV_FFN_ALL) {
            const int mat = r / CV_FFN, item = r % CV_FFN, lf = mat / 3, kind = mat % 3;
            if (kind < 2) {
                const float* W = ap->in[kind == 0 ? I_WG : I_WU] + (size_t)lf * D * DFF;
                const int kb = item / 176, nb = item % 176, n0 = 32 * nb;
                p0_transpose_item(W, DFF, (bf16_t*)(ws + WS_WGU) + (size_t)lf * (2 * DFF) * D, D, 64 * kb, n0, ilv_row(n0, kind), scr, lane);
            } else {
                const float* W = ap->in[I_WD] + (size_t)lf * DFF * D;
                const int kb = item / 64, nb = item % 64, n0 = 32 * nb;
                p0_transpose_item(W, D, (bf16_t*)(ws + WS_WD) + (size_t)lf * D * DFF, DFF, 64 * kb, n0, n0, scr, lane);
            }
            continue;
        }
        r -= CV_FFN_ALL;
        if (r < 4096) { const int kb = r / 128, nb = r % 128, n0 = 32 * nb, sec = n0 >> 10, j0 = n0 & 1023;
            const int drow = (sec == 1 || sec == 2) ? 1024 + ilv_row(j0, sec - 1) : n0;
            p0_transpose_item(ap->in[I_MIXIN], INCOLS, (bf16_t*)(ws + WS_WIN), D, 64 * kb, n0, drow, scr, lane); continue; }
        r -= 4096;
        if (r < 2048) { const int kb = r / 64, nb = r % 64;
            p0_transpose_item(ap->in[I_MIXOUT], D, (bf16_t*)(ws + (kb < 16 ? WS_WOUT : WS_TMP)), D, 64 * kb, 32 * nb, 32 * nb, scr, lane); continue; }
        r -= 2048;
        if (r < 128) {
#pragma unroll
            for (int i = 0; i < 8; ++i) { const int row = 8 * r + i;
                const f32x4 v = *(const f32x4*)(ap->in[I_POOLW] + (size_t)row * 256 + 4 * lane) * *(const f32x4*)(ap->in[I_POOLS] + (row >> 8) * 256 + 4 * lane);
                u32x2 w; w.x = pk2(v.x, v.y); w.y = pk2(v.z, v.w); *(GAS u32x2*)((bf16_t*)(ws + WS_PWT) + (size_t)row * 256 + 4 * lane) = w; }
            continue; }
        r -= 128;
        { const int which = r / 2048, item = r % 2048, kb = item / 64, nb = item % 64, n0 = 32 * nb;
          p0_transpose_item(ap->in[which == 0 ? I_GLUA : I_GLUB], D, (bf16_t*)(ws + WS_WAB), D, 64 * kb, n0, ilv_row(n0, which), scr, lane); }
    }
}
__device__ __forceinline__ void convert_in_tail(ArgsP ap, Frame& F, int first_idle, int lo0, int hi0, int lo1, int hi1) {
    if ((int)blockIdx.x < first_idle) return;
    LAS float* scr = (LAS float*)(F.lds + F.wave * 16384);
    const int wrank = ((int)blockIdx.x - first_idle) * NWAVES + F.wave, nw = (F.G - first_idle) * NWAVES;
    convert_items(ap, lo0, hi0, wrank, nw, scr, F.lane);
    convert_items(ap, lo1, hi1, wrank, nw, scr, F.lane);
}
__device__ __forceinline__ void p0_prologue(ArgsP ap, Frame& F) {
    unsigned char* ws = ap->ws;
    convert_items(ap, 0, 3 * CV_FFN, F.vcu * NWAVES + F.wave, F.G * NWAVES, (LAS float*)(F.lds + F.wave * 16384), F.lane);
    __syncthreads();
    {
        LAS float* sc = (LAS float*)(F.lds);
        LAS float* red = (LAS float*)(F.lds + 73728);
        if ((int)blockIdx.x < 288) {
            for (int idx = F.tid; idx < 9 * D; idx += NWAVES * 64) { const int r = idx >> 11, k = idx & (D - 1);
                const float v = r < 8 ? ap->in[I_C][r * D + k] : ap->in[I_CCTX][k]; sc[idx] = v / (1.0f + expf(-v)); }
        }
        __syncthreads();
        float* MOD = (float*)(ws + WS_MOD);
        for (int unit = blockIdx.x; unit < 288; unit += F.G) {
            const int l = unit / 144, n0 = (unit % 144) * 128, kw = F.wave * 256;
            const float* wp = ap->in[I_WMOD] + ((size_t)l * D + kw) * NMODV + n0 + 2 * F.lane;
            f32x2 acc[9];
#pragma unroll
            for (int r = 0; r < 9; ++r) acc[r] = (f32x2){0.f, 0.f};
#pragma unroll 2
            for (int k4 = 0; k4 < 64; ++k4) {
                f32x2 w[4];
#pragma unroll
                for (int j = 0; j < 4; ++j) w[j] = *(const f32x2*)(wp + (size_t)(4 * k4 + j) * NMODV);
#pragma unroll
                for (int r = 0; r < 9; ++r) { const f32x4 s4 = *(const LAS f32x4*)(sc + r * D + kw + 4 * k4);
                    acc[r] += w[0] * s4[0]; acc[r] += w[1] * s4[1]; acc[r] += w[2] * s4[2]; acc[r] += w[3] * s4[3]; }
            }
#pragma unroll
            for (int r = 0; r < 9; ++r) *(LAS f32x2*)(red + (F.wave * 9 + r) * 128 + 2 * F.lane) = acc[r];
            __syncthreads();
            for (int o = F.tid; o < 9 * 128; o += NWAVES * 64) { const int r = o >> 7, cc = o & 127; float s = ap->in[I_BMOD][l * NMODV + n0 + cc];
#pragma unroll
                for (int w = 0; w < 8; ++w) s += red[(w * 9 + r) * 128 + cc];
                MOD[(size_t)(l * 9 + r) * NMODV + n0 + cc] = s; }
            __syncthreads();
        }
    }
}

struct NormP { const void* src_lat; const void* src_ctx; void* dst_lat; void* dst_ctx; int src_f32, dst_f32; const bf16_t* y; bf16_t* h;
               const float* mod_post; const float* g_post; int ipost; float weight;
               const float* mod_pre; const float* g_pre; int ipre; int M, has_post, has_pre; };
__device__ __forceinline__ void norm_phase(Frame& F, const NormP& p) {
    const int gw = F.vcu * NWAVES + F.wave, NGW = F.G * NWAVES;
    const int rpw = (p.M + NGW - 1) / NGW;
    const int R0 = gw * rpw, R1 = (R0 + rpw) < p.M ? (R0 + rpw) : p.M;
    int rcur = -1;
    f32x4 Ap[8], Aq[8], Bq[8];
#pragma unroll
    for (int j = 0; j < 8; ++j) { Ap[j] = (f32x4){0.f, 0.f, 0.f, 0.f}; Aq[j] = Ap[j]; Bq[j] = Ap[j]; }
    for (int R = R0; R < R1; ++R) {
        const int r = R < MLAT ? (R >> 12) : 8;
        if (r != rcur) {
            rcur = r;
            if (p.has_post) { const f32x4* gt = (const f32x4*)(p.mod_post + (size_t)r * NMODV + (3 * p.ipost + 2) * D) + F.lane; const f32x4* gp = (const f32x4*)p.g_post + F.lane;
#pragma unroll
                for (int j = 0; j < 8; ++j) Ap[j] = gt[64 * j] * gp[64 * j] * p.weight; }
            if (p.has_pre) { const f32x4* scl = (const f32x4*)(p.mod_pre + (size_t)r * NMODV + (3 * p.ipre + 1) * D) + F.lane; const f32x4* sh = (const f32x4*)(p.mod_pre + (size_t)r * NMODV + (3 * p.ipre) * D) + F.lane;
                const f32x4* gq = (const f32x4*)p.g_pre + F.lane;
#pragma unroll
                for (int j = 0; j < 8; ++j) { Aq[j] = gq[64 * j] * (scl[64 * j] + 1.0f); Bq[j] = sh[64 * j]; } }
        }
        const size_t roff = R < MLAT ? (size_t)R * D : (size_t)(R - MLAT) * D;
        const void* xsb = R < MLAT ? p.src_lat : p.src_ctx; void* xdb = R < MLAT ? p.dst_lat : p.dst_ctx;
        f32x4 x[8];
        if (p.src_f32) {
#pragma unroll
            for (int j = 0; j < 8; ++j) x[j] = ((const f32x4*)((const float*)xsb + roff))[F.lane + 64 * j];
        } else {
            f16x4 xh[8];
#pragma unroll
            for (int j = 0; j < 8; ++j) xh[j] = ((const f16x4*)((const _Float16*)xsb + roff))[F.lane + 64 * j];
#pragma unroll
            for (int j = 0; j < 8; ++j) x[j] = __builtin_convertvector(xh[j], f32x4);
        }
        if (p.has_post) {
            u32x2 yw[8];
#pragma unroll
            for (int j = 0; j < 8; ++j) yw[j] = ((const u32x2*)(p.y + (size_t)R * D))[F.lane + 64 * j];
            f32x4 yv[8]; float ss = 0.f;
#pragma unroll
            for (int j = 0; j < 8; ++j) { yv[j] = (f32x4){bflo(yw[j].x), bfhi(yw[j].x), bflo(yw[j].y), bfhi(yw[j].y)};
                ss += (yv[j].x * yv[j].x + yv[j].y * yv[j].y) + (yv[j].z * yv[j].z + yv[j].w * yv[j].w); }
            const float rstd = __builtin_amdgcn_rsqf(wave_sum(ss) * (1.0f / D) + EPS);
#pragma unroll
            for (int j = 0; j < 8; ++j) x[j] = x[j] + Ap[j] * (yv[j] * rstd);
            if (p.dst_f32) {
#pragma unroll
                for (int j = 0; j < 8; ++j) ((f32x4*)((float*)xdb + roff))[F.lane + 64 * j] = x[j];
            } else {
#pragma unroll
                for (int j = 0; j < 8; ++j) { const f16x4 xh = __builtin_convertvector(x[j], f16x4); ((f16x4*)((_Float16*)xdb + roff))[F.lane + 64 * j] = xh; x[j] = __builtin_convertvector(xh, f32x4); }
            }
        }
        if (p.has_pre) {
            float ss = 0.f;
#pragma unroll
            for (int j = 0; j < 8; ++j) ss += (x[j].x * x[j].x + x[j].y * x[j].y) + (x[j].z * x[j].z + x[j].w * x[j].w);
            const float rstd = __builtin_amdgcn_rsqf(wave_sum(ss) * (1.0f / D) + EPS);
            u32x2* ho = (u32x2*)(p.h + (size_t)R * D);
#pragma unroll
            for (int j = 0; j < 8; ++j) { const f32x4 v = (x[j] * rstd) * Aq[j] + Bq[j]; u32x2 w; w.x = pk2(v.x, v.y); w.y = pk2(v.z, v.w); ho[F.lane + 64 * j] = w; }
        }
    }
}

__device__ __forceinline__ f32x4 ld_bf4(const bf16_t* p) { const u32x2 w = *(const u32x2*)p; return (f32x4){bflo(w.x), bfhi(w.x), bflo(w.y), bfhi(w.y)}; }
__device__ __forceinline__ void st_bf4(bf16_t* p, f32x4 v) { u32x2 w; w.x = pk2(v.x, v.y); w.y = pk2(v.z, v.w); *(u32x2*)p = w; }
__device__ __forceinline__ void stencil_phase(ArgsP ap, Frame& F) {
    const bf16_t* P = (const bf16_t*)(ap->ws + WS_HID);
    bf16_t* Y2 = (bf16_t*)(ap->ws + WS_H);
    const int gw = F.vcu * NWAVES + F.wave, NGW = F.G * NWAVES;
    constexpr int SEG = 136, NSEG = MALL / SEG;
    static_assert(NSEG * SEG == MALL, "segment size");
    for (int wu = gw; wu < NSEG * 8; wu += NGW) {
        const int seg = wu >> 3, cb = wu & 7, R0 = seg * SEG;
        if (cb < 4) {
            const int ch = 256 * cb + 4 * F.lane;
            const f32x4 w0 = *(const f32x4*)(ap->in[I_CONVW] + ch), w1 = *(const f32x4*)(ap->in[I_CONVW] + MIXA + ch), w2 = *(const f32x4*)(ap->in[I_CONVW] + 2 * MIXA + ch);
            const f32x4 z = (f32x4){0.f, 0.f, 0.f, 0.f};
            const bf16_t* CV = P + MIXA + ch; const bf16_t* GB = P + ch;
            f32x4 prev = (R0 > 0) ? ld_bf4(CV + (size_t)(R0 - 1) * PCOLS) : z;
            f32x4 cur = ld_bf4(CV + (size_t)R0 * PCOLS);
            for (int Rb = R0; Rb < R0 + SEG; Rb += 8) {
                u32x2 nr[8], gr[8];
#pragma unroll
                for (int i = 0; i < 8; ++i) { const int Rn = (Rb + i + 1 < MALL) ? Rb + i + 1 : MALL - 1;
                    nr[i] = *(const u32x2*)(CV + (size_t)Rn * PCOLS); gr[i] = *(const u32x2*)(GB + (size_t)(Rb + i) * PCOLS); }
#pragma unroll
                for (int i = 0; i < 8; ++i) { const int R = Rb + i;
                    const int slo = R < MLAT ? (R & ~(SEQ - 1)) : MLAT + ((R - MLAT) & ~(CTXL - 1)), shi = slo + (R < MLAT ? SEQ : CTXL);
                    const f32x4 nxt = (R + 1 < MALL) ? (f32x4){bflo(nr[i].x), bfhi(nr[i].x), bflo(nr[i].y), bfhi(nr[i].y)} : z;
                    const f32x4 gb = (f32x4){bflo(gr[i].x), bfhi(gr[i].x), bflo(gr[i].y), bfhi(gr[i].y)};
                    const f32x4 pv = (R - 1 >= slo) ? prev : z, nx = (R + 1 < shi) ? nxt : z;
                    st_bf4(Y2 + (size_t)R * D + ch, gb * (w0 * pv + w1 * cur + w2 * nx));
                    prev = cur; cur = nxt; }
            }
        } else {
            const int gi = cb - 4, half = 1 << gi, ch = 256 * gi + 4 * F.lane;
            const bf16_t* U = P + 2 * MIXA + ch;
            f32x4 S = (f32x4){0.f, 0.f, 0.f, 0.f};
            for (int Rb = R0; Rb < R0 + SEG; Rb += 8) {
                u32x2 ur[8], ar[8], sr[8];
#pragma unroll
                for (int i = 0; i < 8; ++i) { const int R = Rb + i, ra = (R + half < MALL) ? R + half : MALL - 1, rs = (R - half > 0) ? R - half : 0;
                    ur[i] = *(const u32x2*)(U + (size_t)R * PCOLS); ar[i] = *(const u32x2*)(U + (size_t)ra * PCOLS); sr[i] = *(const u32x2*)(U + (size_t)rs * PCOLS); }
#pragma unroll
                for (int i = 0; i < 8; ++i) { const int R = Rb + i;
                    const int plo = R < MLAT ? (R & ~63) : MLAT + ((R - MLAT) & ~(CTXL - 1)), phi = plo + (R < MLAT ? 64 : CTXL);
                    const int lo = (R - half) > plo ? (R - half) : plo, hi = (R + half) < phi ? (R + half) : phi;
                    if (R == R0 || R == plo) {
                        S = (f32x4){0.f, 0.f, 0.f, 0.f};
                        for (int k = lo; k < hi; ++k) S += ld_bf4(U + (size_t)k * PCOLS);
                    }
                    const float inv = 1.0f / (float)(hi - lo);
                    const f32x4 u = (f32x4){bflo(ur[i].x), bfhi(ur[i].x), bflo(ur[i].y), bfhi(ur[i].y)};
                    st_bf4(Y2 + (size_t)R * D + MIXA + ch, S * inv - u);
                    if (R + half < phi) S += (f32x4){bflo(ar[i].x), bfhi(ar[i].x), bflo(ar[i].y), bfhi(ar[i].y)};
                    if (R - half >= plo) S -= (f32x4){bflo(sr[i].x), bfhi(sr[i].x), bflo(sr[i].y), bfhi(sr[i].y)};
                }
            }
        }
    }
}

__device__ __forceinline__ void s5_disc(float lre, float lim, float dt, float& lbr, float& lbi, float& fr, float& fi) {
    const float mag = expf(lre * dt); float sn, cs; sincosf(lim * dt, &sn, &cs);
    lbr = mag * cs; lbi = mag * sn;
    const float den = lre * lre + lim * lim, nr = lbr - 1.0f;
    fr = (nr * lre + lbi * lim) / den; fi = (lbi * lre - nr * lim) / den;
}
__device__ __forceinline__ int s5_row(int b, int d, int c, int m) { const int isl = c >= 8, L = isl ? SEQ : CTXL, base = isl ? b * SEQ : MLAT + b * CTXL, pos = 32 * (isl ? c - 8 : c) + m; return base + (d ? L - 1 - pos : pos); }
__device__ __forceinline__ void s5_drive_scan(const bf16x8 Uc, const bf16x8 (&Bq)[4], float lbr, float lbi, float& sre, float& sim, unsigned (&pk)[32]) {
    f32x16 acc[4];
#pragma unroll
    for (int q = 0; q < 4; ++q) { acc[q] = (f32x16){0.f, 0.f, 0.f, 0.f, 0.f, 0.f, 0.f, 0.f, 0.f, 0.f, 0.f, 0.f, 0.f, 0.f, 0.f, 0.f};
        acc[q] = __builtin_amdgcn_mfma_f32_32x32x16_bf16(Uc, Bq[q], acc[q], 0, 0, 0); }
    float bre[2][16], bim[2][16];
#pragma unroll
    for (int i = 0; i < 16; ++i) {
        const unsigned x0 = __builtin_bit_cast(unsigned, (float)acc[0][i]), x1 = __builtin_bit_cast(unsigned, (float)acc[1][i]);
        const unsigned y0 = __builtin_bit_cast(unsigned, (float)acc[2][i]), y1 = __builtin_bit_cast(unsigned, (float)acc[3][i]);
        const auto rr = __builtin_amdgcn_permlane32_swap(x0, x1, false, false);
        const auto ri = __builtin_amdgcn_permlane32_swap(y0, y1, false, false);
        bre[0][i] = __builtin_bit_cast(float, (unsigned)rr[0]); bre[1][i] = __builtin_bit_cast(float, (unsigned)rr[1]);
        bim[0][i] = __builtin_bit_cast(float, (unsigned)ri[0]); bim[1][i] = __builtin_bit_cast(float, (unsigned)ri[1]);
    }
    float cr = sre, ci = sim; const float nlbi = -lbi;
#pragma unroll
    for (int blk = 0; blk < 4; ++blk)
#pragma unroll
        for (int hh = 0; hh < 2; ++hh)
#pragma unroll
            for (int i2 = 0; i2 < 4; ++i2) {
                const int i = 4 * blk + i2, t = 8 * blk + 4 * hh + i2;
                float tr, ti, nre, nim;
                asm("v_fma_f32 %0, %1, %2, %3" : "=v"(tr) : "v"(nlbi), "v"(ci), "v"(bre[hh][i]));
                asm("v_fma_f32 %0, %1, %2, %3" : "=v"(ti) : "v"(lbi), "v"(cr), "v"(bim[hh][i]));
                asm("v_fma_f32 %0, %1, %2, %3" : "=v"(nre) : "v"(lbr), "v"(cr), "v"(tr));
                asm("v_fma_f32 %0, %1, %2, %3" : "=v"(nim) : "v"(lbr), "v"(ci), "v"(ti));
                cr = nre; ci = nim; pk[t] = cvt_pk_bf16(nre, nim);
            }
    sre = cr; sim = ci;
}
__device__ __forceinline__ void s5_readout(const LAS unsigned char* img, const bf16x8 (&Cq)[4], bf16_t* YS, int b, int d, int g, int c, int lane) {
#pragma unroll
    for (int tt = 0; tt < 2; ++tt) {
        const int tl = 16 * tt + (lane & 15);
        f32x4 o = (f32x4){0.f, 0.f, 0.f, 0.f};
#pragma unroll
        for (int ks = 0; ks < 4; ++ks) { const bf16x8 Sf = *(const LAS bf16x8*)(img + tl * 256 + (((4 * ks + (lane >> 4)) ^ (tl & 15)) << 4));
            o = __builtin_amdgcn_mfma_f32_16x16x32_bf16(Cq[ks], Sf, o, 0, 0, 0); }
        const int R = s5_row(b, d, c, tl);
        u32x2 w; w.x = cvt_pk_bf16(o[0], o[1]); w.y = cvt_pk_bf16(o[2], o[3]);
        *(u32x2*)(YS + ((size_t)d * MLAT + R) * D + 16 * g + 4 * (lane >> 4)) = w;
    }
}
__device__ __forceinline__ void s5_phase(ArgsP ap, Frame& F) {
    const bf16_t* H = (const bf16_t*)(ap->ws + WS_H);
    bf16_t* YS = (bf16_t*)(ap->ws + WS_HID);
    LAS unsigned char* my = F.lds + F.wave * 16384;
    const int gw = F.vcu * NWAVES + F.wave, NGW = F.G * NWAVES, lane = F.lane;
    for (int wu = gw; wu < BATCH * 2 * 128; wu += NGW) {
        const int g = wu & 127, d = (wu >> 7) & 1, b = wu >> 8, dg = d * 128 + g;
        const float dt = expf(ap->in[I_LSTEP][dg]);
        float lbr2[2], lbi2[2], fr2[2], fi2[2];
#pragma unroll
        for (int hh = 0; hh < 2; ++hh) { const int p = (lane & 31) + 32 * hh; s5_disc(ap->in[I_LRE][dg * 64 + p], ap->in[I_LIM][dg * 64 + p], dt, lbr2[hh], lbi2[hh], fr2[hh], fi2[hh]); }
        const float lbr = lane < 32 ? lbr2[0] : lbr2[1], lbi = lane < 32 ? lbi2[0] : lbi2[1];
        bf16x8 Bq[4];
#pragma unroll
        for (int hh = 0; hh < 2; ++hh) {
            const int p = (lane & 31) + 32 * hh; const float* bre = ap->in[I_BRE] + ((size_t)dg * 64 + p) * 16 + 8 * (lane >> 5); const float* bim = ap->in[I_BIM] + ((size_t)dg * 64 + p) * 16 + 8 * (lane >> 5);
            const f32x4 r0 = *(const f32x4*)bre, r1 = *(const f32x4*)(bre + 4), i0 = *(const f32x4*)bim, i1 = *(const f32x4*)(bim + 4);
            const float frr = fr2[hh], fii = fi2[hh];
            const f32x4 re0 = r0 * frr - i0 * fii, re1 = r1 * frr - i1 * fii, im0 = i0 * frr + r0 * fii, im1 = i1 * frr + r1 * fii;
            u32x4 wre, wim; wre.x = pk2(re0.x, re0.y); wre.y = pk2(re0.z, re0.w); wre.z = pk2(re1.x, re1.y); wre.w = pk2(re1.z, re1.w);
            wim.x = pk2(im0.x, im0.y); wim.y = pk2(im0.z, im0.w); wim.z = pk2(im1.x, im1.y); wim.w = pk2(im1.z, im1.w);
            Bq[hh] = __builtin_bit_cast(bf16x8, wre); Bq[2 + hh] = __builtin_bit_cast(bf16x8, wim);
        }
        bf16x8 Cq[4];
#pragma unroll
        for (int ks = 0; ks < 4; ++ks) { const int p0 = 16 * ks + 4 * (lane >> 4); const size_t off = ((size_t)dg * 16 + (lane & 15)) * 64 + p0;
            const f32x4 cr = *(const f32x4*)(ap->in[I_CRE] + off), ci = *(const f32x4*)(ap->in[I_CIM] + off);
            u32x4 w; w.x = pk2(cr.x, -ci.x); w.y = pk2(cr.y, -ci.y); w.z = pk2(cr.z, -ci.z); w.w = pk2(cr.w, -ci.w); Cq[ks] = __builtin_bit_cast(bf16x8, w); }
        float sre = 0.f, sim = 0.f;
#define row_of(c, m) s5_row(b, d, (c), (m))
        const int hoff = 16 * g + 8 * (lane >> 5);
        LAS unsigned char* ring = F.lds + S5RING_OFF + F.wave * 3072;
#define S5_DMA(c_) __builtin_amdgcn_global_load_lds((const unsigned*)(H + (size_t)row_of((c_), lane & 31) * D + hoff), (LAS unsigned*)(ring + ((c_) % 3) * 1024), 16, 0, 0)
#define S5_UFRAG(c_) (*(const LAS bf16x8*)(ring + ((c_) % 3) * 1024 + lane * 16))
        S5_DMA(0); S5_DMA(1); S5_DMA(2);
        unsigned pk[32];
        for (int c = 0; c < 8; ++c) {
            asm volatile("s_waitcnt vmcnt(2)" ::: "memory");
            const bf16x8 Uc = S5_UFRAG(c);
            s5_drive_scan(Uc, Bq, lbr, lbi, sre, sim, pk);
            S5_DMA(c + 3);
        }
        for (int c = 8; c < 137; ++c) {
            if (c > 8) s5_readout(my + ((c - 1) & 1) * 8192, Cq, YS, b, d, g, c - 1, lane);
            if (c < 136) {
                if (c >= 11 && c < 133) asm volatile("s_waitcnt vmcnt(6)" ::: "memory");
                else if (c < 11) asm volatile("s_waitcnt vmcnt(2)" ::: "memory");
                else asm volatile("s_waitcnt vmcnt(0)" ::: "memory");
                const bf16x8 Uc = S5_UFRAG(c);
                s5_drive_scan(Uc, Bq, lbr, lbi, sre, sim, pk);
                if (c + 3 < 136) S5_DMA(c + 3);
                LAS unsigned char* wb = my + (c & 1) * 8192;
#pragma unroll
                for (int t = 0; t < 32; ++t) *(LAS unsigned*)(wb + t * 256 + ((((lane >> 2) ^ (t & 15))) << 4) + (lane & 3) * 4) = pk[t];
            }
            asm volatile("s_waitcnt lgkmcnt(0)" ::: "memory");
        }
#undef S5_DMA
#undef S5_UFRAG
    }
}

#undef row_of
__device__ __forceinline__ float gelu_tanh(float x) { const float z = 0.7978845608028654f * (x + 0.044715f * x * x * x); return x * fast_sigmoid(2.0f * z); }
__device__ __forceinline__ void combine_phase(ArgsP ap, Frame& F) {
    bf16_t* H = (bf16_t*)(ap->ws + WS_H); const bf16_t* YS = (const bf16_t*)(ap->ws + WS_HID); const float* dv = ap->in[I_S5D];
    const size_t nvec = (size_t)MLAT * D / 8, stride = (size_t)F.G * NWAVES * 64;
    for (size_t i = (size_t)blockIdx.x * (NWAVES * 64) + F.tid; i < nvec; i += stride) {
        const int c0 = (int)((i * 8) & (D - 1));
        const u32x4 hw = *(const u32x4*)(H + i * 8), y0 = *(const u32x4*)(YS + i * 8), y1 = *(const u32x4*)(YS + (size_t)MLAT * D + i * 8);
        const f32x4 d0 = *(const f32x4*)(dv + c0), d1 = *(const f32x4*)(dv + c0 + 4);
        float v[8];
        v[0] = bflo(hw.x) * d0.x + bflo(y0.x) + bflo(y1.x); v[1] = bfhi(hw.x) * d0.y + bfhi(y0.x) + bfhi(y1.x);
        v[2] = bflo(hw.y) * d0.z + bflo(y0.y) + bflo(y1.y); v[3] = bfhi(hw.y) * d0.w + bfhi(y0.y) + bfhi(y1.y);
        v[4] = bflo(hw.z) * d1.x + bflo(y0.z) + bflo(y1.z); v[5] = bfhi(hw.z) * d1.y + bfhi(y0.z) + bfhi(y1.z);
        v[6] = bflo(hw.w) * d1.z + bflo(y0.w) + bflo(y1.w); v[7] = bfhi(hw.w) * d1.w + bfhi(y0.w) + bfhi(y1.w);
#pragma unroll
        for (int j = 0; j < 8; ++j) v[j] = gelu_tanh(v[j]);
        u32x4 o; o.x = pk2(v[0], v[1]); o.y = pk2(v[2], v[3]); o.z = pk2(v[4], v[5]); o.w = pk2(v[6], v[7]);
        *(u32x4*)(H + i * 8) = o;
    }
}

constexpr int N_PHASES = 22;
__device__ __forceinline__ Frame make_frame(LAS unsigned char* lds, int tid) {
    Frame F; F.lds = lds; F.tid = tid; F.lane = tid & 63; F.wave = __builtin_amdgcn_readfirstlane(tid >> 6);
    F.G = gridDim.x; { const int bx = blockIdx.x; F.vcu = (F.G % 8 == 0) ? (bx % 8) * (F.G / 8) + bx / 8 : bx; }
    return F;
}
__global__ void __launch_bounds__(NWAVES * 64, 2) fwd_kernel(Args args_unused) {
    extern __shared__ __attribute__((aligned(16))) unsigned char lds[];
    LAS unsigned char* const L = (LAS unsigned char*)lds;
    unsigned long long kp = (unsigned long long)__builtin_amdgcn_kernarg_segment_ptr();
    int tid0 = threadIdx.x;
    volatile LAS unsigned* MISC = (volatile LAS unsigned*)(L + MISC_OFF);
    for (int u = tid0; u < (LDS_BYTES - LDSCTL_OFF) / 4; u += NWAVES * 64) ((LAS unsigned*)(L + LDSCTL_OFF))[u] = 0u;
    __syncthreads();
    const int lo = ((ArgsP)kp)->ph_lo, hi = ((ArgsP)kp)->ph_hi;
    XcdBarrier bar; bar.bar = (unsigned*)(((ArgsP)kp)->ws + WS_CTL) + CW_BAR; bar.x = 0; bar.st = nullptr;
    if (hi - lo > 1) bar = xcd_barrier_post(bar.bar, MISC + 8);
    int ph = 0;
#define PH_ON (ph >= lo && ph < hi)
#define PH_BEGIN asm volatile("" : "+s"(kp)); int tid = tid0; asm volatile("" : "+v"(tid)); const ArgsP ap = (ArgsP)kp; Frame F = make_frame(L, tid); unsigned char* const ws = ap->ws; (void)ws; (void)F;
#define PH_END do { if (ph >= lo && ph + 1 < hi) xcd_barrier(bar); ++ph; } while (0)
#define WSP(T, off) ((T*)(ws + (off)))

    if (PH_ON) { PH_BEGIN; p0_prologue(ap, F); }
    PH_END;

    for (int s = 0; s < 4; ++s) {
        const int l = s >> 1, Ms = (s == 3) ? MLAT : MALL;
        if (PH_ON) {
            PH_BEGIN;
            const float* MOD = WSP(const float, WS_MOD); const float* NG = ap->in[I_NORMG]; void* X = WSP(void, WS_X16); void* XC = WSP(void, WS_XC);
            NormP p{};
            p.y = WSP(const bf16_t, WS_Y); p.h = WSP(bf16_t, WS_H); p.M = Ms; p.has_pre = 1;
            p.mod_pre = MOD + (size_t)l * 9 * NMODV; p.ipre = (s & 1) ? 2 : 0; p.g_pre = NG + (size_t)(l * 6 + 2 * p.ipre) * D;
            if (s == 0) { p.has_post = 0; p.src_lat = ap->in[I_X]; p.src_ctx = ap->in[I_CTX]; p.src_f32 = 1; p.dst_lat = X; p.dst_ctx = XC; p.mod_post = MOD; p.g_post = NG; p.ipost = 0; p.weight = 0.f; }
            else { const int lp = (s == 2) ? 0 : l, ip = (s == 2) ? 2 : 1;
                p.has_post = 1; p.src_lat = X; p.src_ctx = XC; p.dst_lat = X; p.dst_ctx = XC; p.mod_post = MOD + (size_t)lp * 9 * NMODV; p.ipost = ip; p.g_post = NG + (size_t)(lp * 6 + 2 * ip + 1) * D; p.weight = (ip == 1) ? 1.0f : 0.5f; }
            norm_phase(F, p);
        }
        PH_END;
        if (PH_ON) {
            PH_BEGIN;
            pg8::Gemm g{WSP(const bf16_t, WS_H), WSP(const bf16_t, WS_WGU) + (size_t)s * (2 * DFF) * D, Ms, 2 * DFF, D, D, D, 0};
            pg8::StaticOrder S; S.init(Ms, 2 * DFF, F.G, (int)blockIdx.x);
            pg8::EpiGated<0> E{WSP(bf16_t, WS_HID), DFF};
            pg8::gemm_phase<pg8::EpiGated<0>, pg8::StaticOrder, true, true>(L, g, S, E, tid);
        }
        PH_END;
        if (PH_ON) {
            PH_BEGIN;
            pg8::Gemm g{WSP(const bf16_t, WS_HID), WSP(const bf16_t, WS_WD) + (size_t)s * D * DFF, Ms, D, DFF, DFF, DFF, 0};
            pg8::StaticOrder S; S.init(Ms, D, F.G, (int)blockIdx.x, 4, 1, 1);
            pg8::EpiBf16 E{WSP(bf16_t, WS_Y), D, nullptr};
            pg8::gemm_phase<pg8::EpiBf16, pg8::StaticOrder, false, true>(L, g, S, E, tid);
            if (s < 3) {
                const int nu = (MALL / 256) * (D / 256), fi = nu % F.G;
                __syncthreads();
                if (s == 0) convert_in_tail(ap, F, fi, 3 * CV_FFN, 6 * CV_FFN, CV_MIX0, CV_MIX1);
                else if (s == 1) convert_in_tail(ap, F, fi, 6 * CV_FFN, 9 * CV_FFN, 0, 0);
                else convert_in_tail(ap, F, fi, 9 * CV_FFN, 12 * CV_FFN, CV_MIX1, CV_GLU1);
            }
        }
        PH_END;
        if (s == 0 || s == 2) {
            if (PH_ON) {
                PH_BEGIN;
                const float* MOD = WSP(const float, WS_MOD); const float* NG = ap->in[I_NORMG]; void* X = WSP(void, WS_X16); void* XC = WSP(void, WS_XC);
                NormP p{};
                p.y = WSP(const bf16_t, WS_Y); p.h = WSP(bf16_t, WS_H); p.M = MALL; p.has_pre = 1; p.has_post = 1;
                p.src_lat = (s == 0) ? (const void*)ap->in[I_X] : (const void*)X; p.src_ctx = (s == 0) ? (const void*)ap->in[I_CTX] : (const void*)XC; p.src_f32 = (s == 0); p.dst_lat = X; p.dst_ctx = XC;
                p.mod_post = MOD + (size_t)l * 9 * NMODV; p.ipost = 0; p.g_post = NG + (size_t)(l * 6 + 1) * D; p.weight = 0.5f;
                p.mod_pre = MOD + (size_t)l * 9 * NMODV; p.ipre = 1; p.g_pre = NG + (size_t)(l * 6 + 2) * D;
                norm_phase(F, p);
            }
            PH_END;
        }
        if (s == 0) {
            if (PH_ON) {
                PH_BEGIN;
                pg8::Gemm g{WSP(const bf16_t, WS_H), WSP(const bf16_t, WS_WIN), MALL, INCOLS, D, D, D, 0};
                pg8::StaticOrder S; S.init(MALL, INCOLS, F.G, (int)blockIdx.x);
                pg8::EpiInProj E{WSP(bf16_t, WS_HID), PCOLS};
                pg8::gemm_phase<pg8::EpiInProj, pg8::StaticOrder, true, true>(L, g, S, E, tid);
            }
            if (PH_ON) {
                PH_BEGIN;
                const int nui = (MALL / 256) * (INCOLS / 256), fii = nui % F.G;
                if ((int)blockIdx.x >= fii) {
                    pg8::Gemm g{WSP(const bf16_t, WS_TMP) + MIXA, WSP(const bf16_t, WS_PWT), D, 1024, 256, D, 256, 256};
                    pg8::StaticOrder S; S.init(D, 1024, F.G - fii, (int)blockIdx.x - fii);
                    pg8::EpiBf16 E{WSP(bf16_t, WS_WOUT) + MIXA, D, nullptr};
                    pg8::gemm_phase<pg8::EpiBf16, pg8::StaticOrder, true, true>(L, g, S, E, tid);
                }
            }
            PH_END;
            if (PH_ON) { PH_BEGIN; stencil_phase(ap, F); }
            PH_END;
            if (PH_ON) {
                PH_BEGIN;
                pg8::Gemm g{WSP(const bf16_t, WS_H), WSP(const bf16_t, WS_WOUT), MALL, D, D, D, D, 0};
                pg8::StaticOrder S; S.init(MALL, D, F.G, (int)blockIdx.x, 4, 0, 1);
                pg8::EpiBf16 E{WSP(bf16_t, WS_Y), D, nullptr};
                pg8::gemm_phase<pg8::EpiBf16, pg8::StaticOrder, true, true>(L, g, S, E, tid);
            }
            PH_END;
        }
        if (s == 2) {
            if (PH_ON) { PH_BEGIN; s5_phase(ap, F); }
            PH_END;
            if (PH_ON) { PH_BEGIN; combine_phase(ap, F); }
            PH_END;
            if (PH_ON) {
                PH_BEGIN;
                pg8::Gemm g{WSP(const bf16_t, WS_H), WSP(const bf16_t, WS_WAB), MLAT, 2 * D, D, D, D, 0};
                pg8::StaticOrder S; S.init(MLAT, 2 * D, F.G, (int)blockIdx.x);
                pg8::EpiGated<1> E{WSP(bf16_t, WS_Y), D};
                pg8::gemm_phase<pg8::EpiGated<1>, pg8::StaticOrder, true, true>(L, g, S, E, tid);
            }
            PH_END;
        }
    }
    if (PH_ON) {
        PH_BEGIN;
        const float* MOD = WSP(const float, WS_MOD); const float* NG = ap->in[I_NORMG]; void* X = WSP(void, WS_X16); void* XC = WSP(void, WS_XC);
        NormP p{};
        p.y = WSP(const bf16_t, WS_Y); p.h = WSP(bf16_t, WS_H); p.M = MLAT; p.has_pre = 0; p.has_post = 1;
        p.src_lat = X; p.src_ctx = XC; p.dst_lat = ap->out; p.dst_ctx = XC; p.dst_f32 = 1;
        p.mod_post = MOD + (size_t)9 * NMODV; p.ipost = 2; p.g_post = NG + (size_t)(6 + 5) * D; p.weight = 0.5f;
        p.mod_pre = MOD; p.ipre = 0; p.g_pre = NG;
        norm_phase(F, p);
    }
    PH_END;
#undef PH_ON
#undef PH_BEGIN
#undef PH_END
#undef WSP
}

extern "C" void kernel_launch(void* const* d_in, const int* in_sizes, int n_in, void* d_out, int out_size, void* d_ws, size_t ws_size, hipStream_t stream) {
    static int grid = 0;
    if (grid == 0) {
        if (n_in != N_IN || in_sizes[0] != MLAT * D || out_size != MLAT * D || ws_size < WS_END) {
            fprintf(stderr, "kernel_launch: unexpected shapes (n_in %d, in0 %d, out %d, ws %zu); nothing launched\n", n_in, n_in > 0 ? in_sizes[0] : -1, out_size, ws_size); grid = -1; return; }
        int dev = 0, cus = 0, per_cu = 0;
        if (hipGetDevice(&dev) != hipSuccess || hipDeviceGetAttribute(&cus, hipDeviceAttributeMultiprocessorCount, dev) != hipSuccess) { fprintf(stderr, "kernel_launch: device query failed\n"); grid = -1; return; }
        if (hipFuncSetAttribute((const void*)fwd_kernel, hipFuncAttributeMaxDynamicSharedMemorySize, LDS_BYTES) != hipSuccess) { fprintf(stderr, "kernel_launch: hipFuncSetAttribute failed\n"); grid = -1; return; }
        if (hipOccupancyMaxActiveBlocksPerMultiprocessor(&per_cu, (const void*)fwd_kernel, NWAVES * 64, LDS_BYTES) != hipSuccess || per_cu < 1) {
            fprintf(stderr, "kernel_launch: occupancy query reports %d workgroups per CU; nothing launched\n", per_cu); (void)hipGetLastError(); grid = -1; return; }
        grid = cus;
    }
    if (grid < 0) return;
    if (hipMemsetAsync((char*)d_ws + WS_CTL, 0, CTL_ZERO_BYTES, stream) != hipSuccess) { fprintf(stderr, "kernel_launch: memset failed\n"); return; }
    Args a{};
    for (int i = 0; i < N_IN; ++i) a.in[i] = (const float*)d_in[i];
    a.out = (float*)d_out; a.ws = (unsigned char*)d_ws; a.li = 0; a.pad = 0;
#if MK_PER_PHASE
    for (int k = 0; k < N_PHASES; ++k) { a.ph_lo = k; a.ph_hi = k + 1; hipLaunchKernelGGL(fwd_kernel, dim3(grid), dim3(NWAVES * 64), LDS_BYTES, stream, a); }
#else
    a.ph_lo = 0; a.ph_hi = N_PHASES;
    hipLaunchKernelGGL(fwd_kernel, dim3(grid), dim3(NWAVES * 64), LDS_BYTES, stream, a);
#endif
    const hipError_t le = hipPeekAtLastError();
    if (le != hipSuccess) fprintf(stderr, "kernel_launch: launch failed: %s\n", hipGetErrorName(le));
}
```

```cpp
#include <hip/hip_runtime.h>
#include <stdio.h>

#ifndef MK_PER_PHASE
#define MK_PER_PHASE 0
#endif

#define LAS __attribute__((address_space(3)))
#define GAS __attribute__((address_space(1)))
typedef unsigned short bf16_t;
typedef short bf16x8 __attribute__((ext_vector_type(8)));
typedef float f32x4 __attribute__((ext_vector_type(4)));
typedef float f32x2 __attribute__((ext_vector_type(2)));
typedef float f32x16 __attribute__((ext_vector_type(16)));
typedef unsigned u32x4 __attribute__((ext_vector_type(4)));
typedef unsigned u32x2 __attribute__((ext_vector_type(2)));
typedef GAS unsigned gu32;
typedef _Float16 f16x4 __attribute__((ext_vector_type(4)));

constexpr int D = 2048, BATCH = 8, SEQ = 4096, CTXL = 256, DFF = 5632, NMODV = 9 * D;
constexpr int MLAT = BATCH * SEQ, MCTX = BATCH * CTXL, MALL = MLAT + MCTX;
constexpr int MIXA = 1024, INCOLS = 4096, PCOLS = 3072;
constexpr float EPS = 1e-6f;
enum { I_X = 0, I_C, I_CTX, I_CCTX, I_WMOD, I_BMOD, I_NORMG, I_WG, I_WU, I_WD, I_MIXIN, I_CONVW, I_POOLW, I_POOLS, I_MIXOUT,
       I_LRE, I_LIM, I_LSTEP, I_BRE, I_BIM, I_CRE, I_CIM, I_S5D, I_GLUA, I_GLUB, N_IN };

constexpr size_t MiB = 1u << 20;
constexpr size_t WS_CTL = 0, CTL_ZERO_BYTES = 1 * MiB;
constexpr size_t WS_MOD = 2 * MiB;
constexpr size_t WS_PWT = 4 * MiB;
constexpr size_t WS_WIN = 8 * MiB;
constexpr size_t WS_WOUT = 24 * MiB;
constexpr size_t WS_WAB = 32 * MiB;
constexpr size_t WS_WGU = 48 * MiB;
constexpr size_t WS_WD = 224 * MiB;
constexpr size_t WS_XC = 312 * MiB;
constexpr size_t WS_TMP = 320 * MiB;
constexpr size_t WS_H = 328 * MiB;
constexpr size_t WS_Y = 464 * MiB;
constexpr size_t WS_HID = 600 * MiB;
constexpr size_t WS_X16 = 974 * MiB;
constexpr size_t WS_END = 1102 * MiB;
constexpr int CW_BAR = 4096;

constexpr int RING_BYTES = 131072;
constexpr int LDSCTL_OFF = RING_BYTES, MISC_OFF = LDSCTL_OFF + 320;
constexpr int LDS_BYTES = 163840;
constexpr int S5RING_OFF = 135168;
constexpr int NWAVES = 8;

typedef __bf16 bf16x2_t __attribute__((ext_vector_type(2)));
__device__ __forceinline__ unsigned cvt_pk_bf16(float lo, float hi) { const f32x2 v = {lo, hi}; return __builtin_bit_cast(unsigned, __builtin_convertvector(v, bf16x2_t)); }
__device__ __forceinline__ unsigned pk2(float lo, float hi) { return cvt_pk_bf16(lo, hi); }
__device__ __forceinline__ float bflo(unsigned w) { return __builtin_bit_cast(float, w << 16); }
__device__ __forceinline__ float bfhi(unsigned w) { return __builtin_bit_cast(float, w & 0xffff0000u); }
#define DPP_ADD_(v, ctrl) v += __builtin_bit_cast(float, __builtin_amdgcn_update_dpp(0, __builtin_bit_cast(int, v), ctrl, 0xF, 0xF, true))
__device__ __forceinline__ float wave_sum(float v) {
    DPP_ADD_(v, 0xB1); DPP_ADD_(v, 0x4E); DPP_ADD_(v, 0x141); DPP_ADD_(v, 0x140);
    const int iv = __builtin_bit_cast(int, v);
    return (__builtin_bit_cast(float, __builtin_amdgcn_readlane(iv, 0)) + __builtin_bit_cast(float, __builtin_amdgcn_readlane(iv, 16))) +
           (__builtin_bit_cast(float, __builtin_amdgcn_readlane(iv, 32)) + __builtin_bit_cast(float, __builtin_amdgcn_readlane(iv, 48)));
}
__device__ __forceinline__ float fast_sigmoid(float x) { return __builtin_amdgcn_rcpf(1.0f + __expf(-x)); }
#define LDS_WAIT() asm volatile("s_waitcnt lgkmcnt(0)" ::: "memory")
#define VM_WAIT() asm volatile("s_waitcnt vmcnt(0)" ::: "memory")
#define RLX_AGENT __ATOMIC_RELAXED, __HIP_MEMORY_SCOPE_AGENT

namespace pg8 {
#define PG8_LAS __attribute__((address_space(3)))
constexpr int BM = 256, BK = 64, HALF = 128, HTB = HALF * BK * 2, STAGE_BYTES = 8 * HTB, NXCD = 8, WGM = 8;
__host__ __device__ __forceinline__ int lds_byte(int r, int c) { const int st = (r >> 4) * 2 + (c >> 5), rr = r & 15, cc = c & 31, ob = rr * 64 + cc * 2; return st * 1024 + (ob ^ (((ob >> 9) & 1) << 5)); }
__host__ __device__ __forceinline__ void stage_rc(int b, int& R, int& C) { const int st = b / 1024, sb = b % 1024, swz = sb ^ (((sb >> 9) & 1) << 5); R = (st >> 1) * 16 + swz / 64; C = (st & 1) * 32 + (swz % 64) / 2; }
__host__ __device__ __forceinline__ int perm32(int rho) { const int n = rho >> 4, i = rho & 15; return 8 * (i >> 2) + 4 * n + (i & 3); }

struct Unit { int pm, pn; };
struct Gemm { const bf16_t* A; const bf16_t* Bt; int M, N, K, lda, ldb, a_pn_off; };

struct StaticOrder {
    int nM, nN, nwg, G, c, wgm, rev, xloc;
    __host__ __device__ void init(int M, int N, int G_, int c_, int wgm_ = WGM, int rev_ = 0, int xloc_ = 0) {
        nM = M / BM; nN = N / BM; nwg = nM * nN; G = G_; c = c_; wgm = wgm_; rev = rev_; xloc = (xloc_ && nM % NXCD == 0 && G_ % NXCD == 0) ? 1 : 0; }
    __host__ __device__ bool next(int i, Unit& u) const {
        const long L = (long)i * G + c; if (L >= nwg) return false;
        if (xloc) {
            const int xcd = (int)L % NXCD, off = (int)L / NXCD, pmx = nM / NXCD, nig = wgm * nN, gid = off / nig, fm = gid * wgm, gsz = (pmx - fm) < wgm ? (pmx - fm) : wgm, idx = off - gid * nig;
            u.pm = xcd * pmx + fm + idx % gsz; u.pn = idx / gsz;
        } else {
            int wgid = (int)L; { const int q = nwg / NXCD, r = nwg % NXCD, xcd = wgid % NXCD, off = wgid / NXCD; wgid = (xcd < r ? xcd * (q + 1) : r * (q + 1) + (xcd - r) * q) + off; }
            const int nig = wgm * nN, gid = wgid / nig, fm = gid * wgm, gsz = (nM - fm) < wgm ? (nM - fm) : wgm;
            u.pm = fm + ((wgid % nig) % gsz); u.pn = (wgid % nig) / gsz;
        }
        if (rev) u.pm = nM - 1 - u.pm; return true;
    }
    __device__ __forceinline__ void a_ready(const Unit&) const {}
    __device__ __forceinline__ void done(const Unit&) const {}
};

struct EpiBf16 {
    static constexpr bool PERM = true, AFTER_DRAIN = false;
    bf16_t* O; int ldc; const float* colscale;
    __device__ __forceinline__ void operator()(const f32x4 (&acc)[2][2][4][2], const Unit& u, int wr, int wc, int fr, int fq) const {
        const int row0 = u.pm * BM + wr * 64 + fr, col0 = u.pn * BM + wc * 32 + 8 * fq;
        f32x4 sv[2][2];
#pragma unroll
        for (int bj = 0; bj < 2; ++bj)
#pragma unroll
            for (int n = 0; n < 2; ++n) sv[bj][n] = colscale ? *(const f32x4*)(colscale + col0 + bj * HALF + 4 * n) : (f32x4){1.f, 1.f, 1.f, 1.f};
#pragma unroll
        for (int ai = 0; ai < 2; ++ai)
#pragma unroll
            for (int m = 0; m < 4; ++m) { bf16_t* rowp = O + (size_t)(row0 + ai * HALF + m * 16) * ldc + col0;
#pragma unroll
                for (int bj = 0; bj < 2; ++bj) { const f32x4 v0 = acc[ai][bj][m][0] * sv[bj][0], v1 = acc[ai][bj][m][1] * sv[bj][1];
                    u32x4 w; w.x = cvt_pk_bf16(v0[0], v0[1]); w.y = cvt_pk_bf16(v0[2], v0[3]); w.z = cvt_pk_bf16(v1[0], v1[1]); w.w = cvt_pk_bf16(v1[2], v1[3]);
                    *(u32x4*)(rowp + bj * HALF) = w; } }
    }
};
struct EpiInProj {
    static constexpr bool PERM = true, AFTER_DRAIN = false;
    bf16_t* O; int ldc;
    __device__ __forceinline__ void operator()(const f32x4 (&acc)[2][2][4][2], const Unit& u, int wr, int wc, int fr, int fq) const {
        const int row0 = u.pm * BM + wr * 64 + fr;
        if (u.pn >= 4 && u.pn < 12) {
            const int col0 = 1024 + (u.pn - 4) * HALF + wc * 32 + 8 * fq;
#pragma unroll
            for (int ai = 0; ai < 2; ++ai)
#pragma unroll
                for (int m = 0; m < 4; ++m) { bf16_t* rowp = O + (size_t)(row0 + ai * HALF + m * 16) * ldc + col0;
                    const f32x4 p0 = acc[ai][0][m][0] * acc[ai][1][m][0], p1 = acc[ai][0][m][1] * acc[ai][1][m][1];
                    u32x4 w; w.x = cvt_pk_bf16(p0[0], p0[1]); w.y = cvt_pk_bf16(p0[2], p0[3]); w.z = cvt_pk_bf16(p1[0], p1[1]); w.w = cvt_pk_bf16(p1[2], p1[3]);
                    *(u32x4*)rowp = w; }
        } else {
            const int col0 = (u.pn < 4 ? u.pn * BM : 2048 + (u.pn - 12) * BM) + wc * 32 + 8 * fq;
#pragma unroll
            for (int ai = 0; ai < 2; ++ai)
#pragma unroll
                for (int m = 0; m < 4; ++m) { bf16_t* rowp = O + (size_t)(row0 + ai * HALF + m * 16) * ldc + col0;
#pragma unroll
                    for (int bj = 0; bj < 2; ++bj) { const f32x4 v0 = acc[ai][bj][m][0], v1 = acc[ai][bj][m][1];
                        u32x4 w; w.x = cvt_pk_bf16(v0[0], v0[1]); w.y = cvt_pk_bf16(v0[2], v0[3]); w.z = cvt_pk_bf16(v1[0], v1[1]); w.w = cvt_pk_bf16(v1[2], v1[3]);
                        *(u32x4*)(rowp + bj * HALF) = w; } }
        }
    }
};
template <int MODE> struct EpiGated {
    static constexpr bool PERM = true, AFTER_DRAIN = false;
    bf16_t* O; int ldc;
    __device__ __forceinline__ void operator()(const f32x4 (&acc)[2][2][4][2], const Unit& u, int wr, int wc, int fr, int fq) const {
        const int row0 = u.pm * BM + wr * 64 + fr, col0 = u.pn * HALF + wc * 32 + 8 * fq;
#pragma unroll
        for (int ai = 0; ai < 2; ++ai)
#pragma unroll
            for (int m = 0; m < 4; ++m) { bf16_t* rowp = O + (size_t)(row0 + ai * HALF + m * 16) * ldc + col0;
                float o[8];
#pragma unroll
                for (int n = 0; n < 2; ++n)
#pragma unroll
                    for (int j = 0; j < 4; ++j) { const float a = acc[ai][0][m][n][j], b = acc[ai][1][m][n][j];
                        o[4 * n + j] = (MODE == 0) ? (a * fast_sigmoid(a)) * b : a * fast_sigmoid(b); }
                u32x4 w; w.x = cvt_pk_bf16(o[0], o[1]); w.y = cvt_pk_bf16(o[2], o[3]); w.z = cvt_pk_bf16(o[4], o[5]); w.w = cvt_pk_bf16(o[6], o[7]);
                *(u32x4*)rowp = w; }
    }
};

template <class Epi, class Sched, bool ALIGN_EPI = false, bool SP2 = false>
__device__ __forceinline__ void gemm_phase(PG8_LAS unsigned char* lds, const Gemm g, const Sched& S, const Epi& E, const int tid) {
    const int wid = __builtin_amdgcn_readfirstlane(tid >> 6), lane = tid & 63, wr = wid >> 2, wc = wid & 3, fr = lane & 15, fq = lane >> 4;
    const int K = g.K, nt = K / BK;
    unsigned voffA[2], voffB[2];
#pragma unroll
    for (int i = 0; i < 2; ++i) { int R, C; stage_rc(tid * 16 + i * 8192, R, C); const int Rb = Epi::PERM ? ((R & ~31) + perm32(R & 31)) : R;
        voffA[i] = (unsigned)(R * g.lda + C) * 2u; voffB[i] = (unsigned)(Rb * g.ldb + C) * 2u; }
    const size_t kstep = (size_t)(BK * 2);
    const size_t hstepA = (size_t)HALF * g.lda * 2, hstepB = (size_t)HALF * g.ldb * 2;
    const size_t tstepA = 2 * hstepA, tstepB = 2 * hstepB;
    const size_t pnA = (size_t)g.a_pn_off * 2;
    const unsigned ldsw = (unsigned)wid * 1024u;
    const int aoff = lds_byte(wr * 64 + fr, fq * 8), boff = lds_byte(wc * 32 + fr, fq * 8);
#define PG8_SA(b, h) (((b) * 2 + (h)) * HTB)
#define PG8_SB(b, h) ((4 + (b) * 2 + (h)) * HTB)
#define PG8_STAGE(bufoff, gbase, voff) do { _Pragma("unroll") for (int _i = 0; _i < 2; ++_i) \
        __builtin_amdgcn_global_load_lds((const unsigned*)((const char*)(gbase) + (voff)[_i]), (PG8_LAS unsigned*)(lds + (bufoff) + ldsw + _i * 8192), 16, 0, 0); } while (0)
#define PG8_LDA(dst, b, h) do { _Pragma("unroll") for (int m = 0; m < 4; ++m) _Pragma("unroll") for (int k = 0; k < 2; ++k) dst[m][k] = *(const PG8_LAS bf16x8*)(lds + PG8_SA(b, h) + aoff + m * 2048 + k * 1024); } while (0)
#define PG8_LDB(dst, b, h) do { _Pragma("unroll") for (int n = 0; n < 2; ++n) _Pragma("unroll") for (int k = 0; k < 2; ++k) dst[n][k] = *(const PG8_LAS bf16x8*)(lds + PG8_SB(b, h) + boff + n * 2048 + k * 1024); } while (0)
#define PG8_MMA(ai, bj, At, Bt) do { __builtin_amdgcn_s_setprio(1); _Pragma("unroll") for (int m = 0; m < 4; ++m) _Pragma("unroll") for (int n = 0; n < 2; ++n) _Pragma("unroll") for (int k = 0; k < 2; ++k) \
        acc[ai][bj][m][n] = __builtin_amdgcn_mfma_f32_16x16x32_bf16(Bt[n][k], At[m][k], acc[ai][bj][m][n], 0, 0, 0); __builtin_amdgcn_s_setprio(0); } while (0)
#define PG8_WAIT_V(n) asm volatile("s_waitcnt vmcnt(" #n ")" ::: "memory")
#define PG8_WAIT_L(n) asm volatile("s_waitcnt lgkmcnt(" #n ")" ::: "memory")
#define PG8_BAR __builtin_amdgcn_s_barrier()
#define PG8_SCHED __builtin_amdgcn_sched_barrier(0)
    Unit cur, nxt; int ui = 0;
    if (!S.next(0, cur)) return;
    f32x4 acc[2][2][4][2];
#pragma unroll
    for (int a = 0; a < 2; ++a)
#pragma unroll
        for (int b = 0; b < 2; ++b)
#pragma unroll
            for (int m = 0; m < 4; ++m)
#pragma unroll
                for (int n = 0; n < 2; ++n) acc[a][b][m][n] = (f32x4){0.f, 0.f, 0.f, 0.f};
    bf16x8 At[4][2], B0[2][2], B1[2][2];
    const char* cA = (const char*)g.A + (size_t)cur.pm * tstepA + (size_t)cur.pn * pnA; const char* cB = (const char*)g.Bt + (size_t)cur.pn * tstepB;
    S.a_ready(cur);
    if constexpr (SP2) {
        PG8_STAGE(PG8_SB(0, 0), cB, voffB); PG8_STAGE(PG8_SB(0, 1), cB + hstepB, voffB); PG8_STAGE(PG8_SA(0, 0), cA, voffA); PG8_STAGE(PG8_SA(0, 1), cA + hstepA, voffA);
        if (wr == 1) PG8_BAR;
        PG8_WAIT_V(2); PG8_BAR;
        PG8_STAGE(PG8_SB(1, 0), cB + kstep, voffB); PG8_STAGE(PG8_SA(1, 0), cA + kstep, voffA); PG8_STAGE(PG8_SB(1, 1), cB + hstepB + kstep, voffB);
        PG8_WAIT_V(6); PG8_BAR;
    } else {
        PG8_STAGE(PG8_SB(0, 0), cB, voffB); PG8_STAGE(PG8_SA(0, 0), cA, voffA); PG8_STAGE(PG8_SB(0, 1), cB + hstepB, voffB); PG8_STAGE(PG8_SA(0, 1), cA + hstepA, voffA);
        if (wr == 1) PG8_BAR;
        PG8_WAIT_V(4); PG8_BAR;
        PG8_STAGE(PG8_SB(1, 0), cB + kstep, voffB); PG8_STAGE(PG8_SA(1, 0), cA + kstep, voffA); PG8_STAGE(PG8_SB(1, 1), cB + hstepB + kstep, voffB);
        PG8_WAIT_V(6); PG8_BAR;
    }
    for (;;) {
        const bool has_next = S.next(ui + 1, nxt);
        const char* nA = has_next ? (const char*)g.A + (size_t)nxt.pm * tstepA + (size_t)nxt.pn * pnA : cA; const char* nB = has_next ? (const char*)g.Bt + (size_t)nxt.pn * tstepB : cB;
        for (int t = 0; t < nt; t += 2) {
            const bool last = (t == nt - 2);
            const char* a1 = cA + (size_t)(t + 1) * kstep;
            const char* a2 = last ? nA : cA + (size_t)(t + 2) * kstep; const char* b2 = last ? nB : cB + (size_t)(t + 2) * kstep;
            const char* a3 = a2 + kstep; const char* b3 = b2 + kstep;
            if (last && has_next) S.a_ready(nxt);
            if constexpr (SP2) {
            PG8_LDB(B0, 0, 0); PG8_LDB(B1, 0, 1); PG8_SCHED; PG8_LDA(At, 0, 0); PG8_STAGE(PG8_SA(1, 1), a1 + hstepA, voffA);
            PG8_WAIT_V(8); PG8_WAIT_L(0); PG8_BAR; PG8_MMA(0, 0, At, B0); PG8_MMA(0, 1, At, B1); PG8_BAR; PG8_SCHED;
            PG8_LDA(At, 0, 1); PG8_STAGE(PG8_SB(0, 0), b2, voffB); PG8_STAGE(PG8_SB(0, 1), b2 + hstepB, voffB); PG8_STAGE(PG8_SA(0, 0), a2, voffA);
            PG8_WAIT_V(8); PG8_WAIT_L(0); PG8_BAR; PG8_MMA(1, 0, At, B0); PG8_MMA(1, 1, At, B1); PG8_BAR; PG8_SCHED;
            PG8_LDB(B0, 1, 0); PG8_LDB(B1, 1, 1); PG8_SCHED; PG8_LDA(At, 1, 0); PG8_STAGE(PG8_SA(0, 1), a2 + hstepA, voffA);
            PG8_WAIT_V(8); PG8_WAIT_L(0); PG8_BAR; PG8_MMA(0, 0, At, B0); PG8_MMA(0, 1, At, B1); PG8_BAR; PG8_SCHED;
            PG8_LDA(At, 1, 1); PG8_STAGE(PG8_SB(1, 0), b3, voffB); PG8_STAGE(PG8_SB(1, 1), b3 + hstepB, voffB); PG8_STAGE(PG8_SA(1, 0), a3, voffA);
            PG8_WAIT_V(8); PG8_WAIT_L(0); PG8_BAR; PG8_MMA(1, 0, At, B0); PG8_MMA(1, 1, At, B1); PG8_BAR; PG8_SCHED;
            } else {
            PG8_LDB(B0, 0, 0); PG8_SCHED; PG8_LDA(At, 0, 0); PG8_STAGE(PG8_SA(1, 1), a1 + hstepA, voffA);
            PG8_WAIT_L(8); PG8_BAR; PG8_WAIT_L(0); PG8_MMA(0, 0, At, B0); PG8_BAR; PG8_SCHED;
            PG8_LDB(B1, 0, 1); PG8_STAGE(PG8_SB(0, 0), b2, voffB);
            PG8_BAR; PG8_WAIT_L(0); PG8_MMA(0, 1, At, B1); PG8_BAR;
            PG8_LDA(At, 0, 1); PG8_STAGE(PG8_SA(0, 0), a2, voffA);
            PG8_BAR; PG8_WAIT_L(0); PG8_MMA(1, 0, At, B0); PG8_BAR; PG8_SCHED;
            PG8_STAGE(PG8_SB(0, 1), b2 + hstepB, voffB);
            PG8_WAIT_V(6); PG8_BAR; PG8_MMA(1, 1, At, B1); PG8_BAR;
            PG8_LDB(B0, 1, 0); PG8_SCHED; PG8_LDA(At, 1, 0); PG8_STAGE(PG8_SA(0, 1), a2 + hstepA, voffA);
            PG8_WAIT_L(8); PG8_BAR; PG8_WAIT_L(0); PG8_MMA(0, 0, At, B0); PG8_BAR; PG8_SCHED;
            PG8_LDB(B1, 1, 1); PG8_STAGE(PG8_SB(1, 0), b3, voffB);
            PG8_BAR; PG8_WAIT_L(0); PG8_MMA(0, 1, At, B1); PG8_BAR;
            PG8_LDA(At, 1, 1); PG8_STAGE(PG8_SA(1, 0), a3, voffA);
            PG8_BAR; PG8_WAIT_L(0); PG8_MMA(1, 0, At, B0); PG8_BAR; PG8_SCHED;
            PG8_STAGE(PG8_SB(1, 1), b3 + hstepB, voffB);
            PG8_WAIT_V(6); PG8_BAR; PG8_MMA(1, 1, At, B1); PG8_BAR;
            }
        }
        if constexpr (ALIGN_EPI) { if (wr == 0) PG8_BAR; }
        if constexpr (!Epi::AFTER_DRAIN) { E(acc, cur, wr, wc, fr, fq); S.done(cur); }
        if (!has_next) break;
#pragma unroll
        for (int a = 0; a < 2; ++a)
#pragma unroll
            for (int b = 0; b < 2; ++b)
#pragma unroll
                for (int m = 0; m < 4; ++m)
#pragma unroll
                    for (int n = 0; n < 2; ++n) acc[a][b][m][n] = (f32x4){0.f, 0.f, 0.f, 0.f};
        cur = nxt; cA = nA; cB = nB; ++ui;
        if constexpr (ALIGN_EPI) { if (wr == 1) PG8_BAR; }
    }
    PG8_WAIT_V(0);
    if constexpr (!ALIGN_EPI) { if (wr == 0) PG8_BAR; }
    PG8_BAR;
#undef PG8_SA
#undef PG8_SB
#undef PG8_STAGE
#undef PG8_LDA
#undef PG8_LDB
#undef PG8_MMA
#undef PG8_WAIT_V
#undef PG8_WAIT_L
#undef PG8_BAR
#undef PG8_SCHED
}
}

#define XB_TMO      128
#define XB_XCNT(j)  (256  + 64 * (j))
#define XB_XSUB(j)  (1280 + 64 * (j))
#define XB_XGEN(j)  (2304 + 64 * (j))
#define XB_TOP      3328
#define XB_TOPGEN   3392
#define XCD_BAR_WORDS 3456
#define XB_SPIN_CAP (1u << 18)

__device__ __forceinline__ unsigned xb_ld(unsigned* p)              { return __hip_atomic_load(p, __ATOMIC_RELAXED, __HIP_MEMORY_SCOPE_AGENT); }
__device__ __forceinline__ unsigned xb_add(unsigned* p, unsigned v) { return __hip_atomic_fetch_add(p, v, __ATOMIC_RELAXED, __HIP_MEMORY_SCOPE_AGENT); }
__device__ __forceinline__ unsigned xb_xcc_id() { return (unsigned)__builtin_amdgcn_s_getreg((3 << 11) | 20) & 0xFu; }
#define XB_SPIN(cond, bar) do { unsigned _sp = 0; while (cond) { __builtin_amdgcn_s_sleep(1); \
    if ((++_sp & 255u) == 0u) { if (xb_ld(&(bar)[XB_TMO])) break; if (_sp > XB_SPIN_CAP) { atomicAdd(&(bar)[XB_TMO], 1u); break; } } } } while (0)

struct XcdBarrier { unsigned* bar; unsigned x; volatile LAS unsigned* st; };

__device__ __forceinline__ XcdBarrier xcd_barrier_post(unsigned* bar, volatile LAS unsigned* st) {
    XcdBarrier b; b.bar = bar; b.x = xb_xcc_id(); b.st = st;
    if (threadIdx.x == 0) (void)xb_add(&bar[XB_XCNT(b.x)], 1u);
    return b;
}
__device__ __forceinline__ void xcd_barrier_complete(unsigned* bar, unsigned x, unsigned& nloc, unsigned& nx) {
    const unsigned G = gridDim.x * gridDim.y * gridDim.z;
    unsigned sum, cnt, mine, sp = 0u;
    for (;;) {
        sum = 0u; cnt = 0u; mine = 0u;
#pragma unroll
        for (unsigned j = 0; j < 16; ++j) { const unsigned c = xb_ld(&bar[XB_XCNT(j)]); sum += c; cnt += (c > 0u) ? 1u : 0u; mine = (j == x) ? c : mine; }
        if (sum == G) break;
        __builtin_amdgcn_s_sleep(1);
        if ((++sp & 255u) == 0u) { if (xb_ld(&bar[XB_TMO])) break; if (sp > XB_SPIN_CAP) { atomicAdd(&bar[XB_TMO], 1u); break; } }
    }
    nloc = mine > 0u ? mine : 1u; nx = cnt > 0u ? cnt : 1u;
}
__device__ __forceinline__ void xcd_barrier(const XcdBarrier& b) {
    asm volatile("s_waitcnt vmcnt(0)" ::: "memory");
    __syncthreads();
    if (threadIdx.x == 0) {
        unsigned* bar = b.bar;
        __builtin_amdgcn_s_waitcnt(0);
        unsigned nloc = b.st[0], nx = b.st[1];
        if (nloc == 0u) { xcd_barrier_complete(bar, b.x, nloc, nx); b.st[0] = nloc; b.st[1] = nx; }
        const unsigned old = xb_add(&bar[XB_XSUB(b.x)], 1u);
        const unsigned gen = old / nloc;
        if (old + 1u == (gen + 1u) * nloc) {
            __builtin_amdgcn_fence(__ATOMIC_RELEASE, "agent");
            asm volatile("s_waitcnt vmcnt(0)" ::: "memory");
            const unsigned og = xb_add(&bar[XB_TOP], 1u);
            const unsigned tg = og / nx;
            if (og + 1u == (tg + 1u) * nx) xb_add(&bar[XB_TOPGEN], 1u);
            else XB_SPIN(xb_ld(&bar[XB_TOPGEN]) == tg, bar);
            __builtin_amdgcn_fence(__ATOMIC_ACQUIRE, "agent");
            xb_add(&bar[XB_XGEN(b.x)], 1u);
            asm volatile("s_waitcnt vmcnt(0)" ::: "memory");
        } else {
            XB_SPIN(xb_ld(&bar[XB_XGEN(b.x)]) == gen, bar);
            __builtin_amdgcn_fence(__ATOMIC_ACQUIRE, "agent");
            asm volatile("s_waitcnt vmcnt(0)" ::: "memory");
        }
    }
    __syncthreads();
}

struct Args { const float* in[N_IN]; float* out; unsigned char* ws; int ph_lo, ph_hi, li, pad; };
struct Frame { LAS unsigned char* lds; int tid, lane, wave, vcu, G; };
typedef const __attribute__((address_space(4))) Args* ArgsP;


__device__ __forceinline__ void p0_transpose_item(const float* W, int N, bf16_t* WT, int Kdst, int k0, int n0, int drow0, LAS float* scr, int lane) {
#pragma unroll
    for (int i = 0; i < 32; ++i) { const int kk = 2 * i + (lane >> 5); scr[kk * 33 + (lane & 31)] = W[(size_t)(k0 + kk) * N + n0 + (lane & 31)]; }
    LDS_WAIT(); asm volatile("" ::: "memory");
    const int c = lane & 7;
#pragma unroll
    for (int j = 0; j < 4; ++j) { const int n = (lane >> 3) + 8 * j; const LAS float* s = scr + (8 * c) * 33 + n;
        u32x4 o; o.x = pk2(s[0 * 33], s[1 * 33]); o.y = pk2(s[2 * 33], s[3 * 33]); o.z = pk2(s[4 * 33], s[5 * 33]); o.w = pk2(s[6 * 33], s[7 * 33]);
        *(GAS u32x4*)(WT + (size_t)(drow0 + n) * Kdst + k0 + 8 * c) = o; }
    LDS_WAIT(); asm volatile("" ::: "memory");
}
__device__ __forceinline__ int ilv_row(int n, int hi) { return 256 * (n >> 7) + (n & 127) + 128 * hi; }

constexpr int CV_FFN = 5632, CV_FFN_ALL = 12 * CV_FFN, CV_MIX0 = CV_FFN_ALL, CV_MIX1 = CV_MIX0 + 4096 + 2048 + 128, CV_GLU1 = CV_MIX1 + 4096;
__device__ __forceinline__ void convert_items(ArgsP ap, int lo, int hi, int wrank, int nw, LAS float* scr, int lane) {
    unsigned char* ws = ap->ws;
    for (int it = lo + wrank; it < hi; it += nw) {
        int r = it;
        if (r < CV_FFN_ALL) {
            const int mat = r / CV_FFN, item = r % CV_FFN, lf = mat / 3, kind = mat % 3;
            if (kind < 2) {
                const float* W = ap->in[kind == 0 ? I_WG : I_WU] + (size_t)lf * D * DFF;
                const int kb = item / 176, nb = item % 176, n0 = 32 * nb;
                p0_transpose_item(W, DFF, (bf16_t*)(ws + WS_WGU) + (size_t)lf * (2 * DFF) * D, D, 64 * kb, n0, ilv_row(n0, kind), scr, lane);
            } else {
                const float* W = ap->in[I_WD] + (size_t)lf * DFF * D;
                const int kb = item / 64, nb = item % 64, n0 = 32 * nb;
                p0_transpose_item(W, D, (bf16_t*)(ws + WS_WD) + (size_t)lf * D * DFF, DFF, 64 * kb, n0, n0, scr, lane);
            }
            continue;
        }
        r -= CV_FFN_ALL;
        if (r < 4096) { const int kb = r / 128, nb = r % 128, n0 = 32 * nb, sec = n0 >> 10, j0 = n0 & 1023;
            const int drow = (sec == 1 || sec == 2) ? 1024 + ilv_row(j0, sec - 1) : n0;
            p0_transpose_item(ap->in[I_MIXIN], INCOLS, (bf16_t*)(ws + WS_WIN), D, 64 * kb, n0, drow, scr, lane); continue; }
        r -= 4096;
        if (r < 2048) { const int kb = r / 64, nb = r % 64;
            p0_transpose_item(ap->in[I_MIXOUT], D, (bf16_t*)(ws + (kb < 16 ? WS_WOUT : WS_TMP)), D, 64 * kb, 32 * nb, 32 * nb, scr, lane); continue; }
        r -= 2048;
        if (r < 128) {
#pragma unroll
            for (int i = 0; i < 8; ++i) { const int row = 8 * r + i;
                const f32x4 v = *(const f32x4*)(ap->in[I_POOLW] + (size_t)row * 256 + 4 * lane) * *(const f32x4*)(ap->in[I_POOLS] + (row >> 8) * 256 + 4 * lane);
                u32x2 w; w.x = pk2(v.x, v.y); w.y = pk2(v.z, v.w); *(GAS u32x2*)((bf16_t*)(ws + WS_PWT) + (size_t)row * 256 + 4 * lane) = w; }
            continue; }
        r -= 128;
        { const int which = r / 2048, item = r % 2048, kb = item / 64, nb = item % 64, n0 = 32 * nb;
          p0_transpose_item(ap->in[which == 0 ? I_GLUA : I_GLUB], D, (bf16_t*)(ws + WS_WAB), D, 64 * kb, n0, ilv_row(n0, which), scr, lane); }
    }
}
__device__ __forceinline__ void convert_in_tail(ArgsP ap, Frame& F, int first_idle, int lo0, int hi0, int lo1, int hi1) {
    if ((int)blockIdx.x < first_idle) return;
    LAS float* scr = (LAS float*)(F.lds + F.wave * 16384);
    const int wrank = ((int)blockIdx.x - first_idle) * NWAVES + F.wave, nw = (F.G - first_idle) * NWAVES;
    convert_items(ap, lo0, hi0, wrank, nw, scr, F.lane);
    convert_items(ap, lo1, hi1, wrank, nw, scr, F.lane);
}
__device__ __forceinline__ void p0_prologue(ArgsP ap, Frame& F) {
    unsigned char* ws = ap->ws;
    convert_items(ap, 0, 3 * CV_FFN, F.vcu * NWAVES + F.wave, F.G * NWAVES, (LAS float*)(F.lds + F.wave * 16384), F.lane);
    __syncthreads();
    {
        LAS float* sc = (LAS float*)(F.lds);
        LAS float* red = (LAS float*)(F.lds + 73728);
        if ((int)blockIdx.x < 288) {
            for (int idx = F.tid; idx < 9 * D; idx += NWAVES * 64) { const int r = idx >> 11, k = idx & (D - 1);
                const float v = r < 8 ? ap->in[I_C][r * D + k] : ap->in[I_CCTX][k]; sc[idx] = v / (1.0f + expf(-v)); }
        }
        __syncthreads();
        float* MOD = (float*)(ws + WS_MOD);
        for (int unit = blockIdx.x; unit < 288; unit += F.G) {
            const int l = unit / 144, n0 = (unit % 144) * 128, kw = F.wave * 256;
            const float* wp = ap->in[I_WMOD] + ((size_t)l * D + kw) * NMODV + n0 + 2 * F.lane;
            f32x2 acc[9];
#pragma unroll
            for (int r = 0; r < 9; ++r) acc[r] = (f32x2){0.f, 0.f};
#pragma unroll 2
            for (int k4 = 0; k4 < 64; ++k4) {
                f32x2 w[4];
#pragma unroll
                for (int j = 0; j < 4; ++j) w[j] = *(const f32x2*)(wp + (size_t)(4 * k4 + j) * NMODV);
#pragma unroll
                for (int r = 0; r < 9; ++r) { const f32x4 s4 = *(const LAS f32x4*)(sc + r * D + kw + 4 * k4);
                    acc[r] += w[0] * s4[0]; acc[r] += w[1] * s4[1]; acc[r] += w[2] * s4[2]; acc[r] += w[3] * s4[3]; }
            }
#pragma unroll
            for (int r = 0; r < 9; ++r) *(LAS f32x2*)(red + (F.wave * 9 + r) * 128 + 2 * F.lane) = acc[r];
            __syncthreads();
            for (int o = F.tid; o < 9 * 128; o += NWAVES * 64) { const int r = o >> 7, cc = o & 127; float s = ap->in[I_BMOD][l * NMODV + n0 + cc];
#pragma unroll
                for (int w = 0; w < 8; ++w) s += red[(w * 9 + r) * 128 + cc];
                MOD[(size_t)(l * 9 + r) * NMODV + n0 + cc] = s; }
            __syncthreads();
        }
    }
}

struct NormP { const void* src_lat; const void* src_ctx; void* dst_lat; void* dst_ctx; int src_f32, dst_f32; const bf16_t* y; bf16_t* h;
               const float* mod_post; const float* g_post; int ipost; float weight;
               const float* mod_pre; const float* g_pre; int ipre; int M, has_post, has_pre; };
__device__ __forceinline__ void norm_phase(Frame& F, const NormP& p) {
    const int gw = F.vcu * NWAVES + F.wave, NGW = F.G * NWAVES;
    const int rpw = (p.M + NGW - 1) / NGW;
    const int R0 = gw * rpw, R1 = (R0 + rpw) < p.M ? (R0 + rpw) : p.M;
    int rcur = -1;
    f32x4 Ap[8], Aq[8], Bq[8];
#pragma unroll
    for (int j = 0; j < 8; ++j) { Ap[j] = (f32x4){0.f, 0.f, 0.f, 0.f}; Aq[j] = Ap[j]; Bq[j] = Ap[j]; }
    for (int R = R0; R < R1; ++R) {
        const int r = R < MLAT ? (R >> 12) : 8;
        if (r != rcur) {
            rcur = r;
            if (p.has_post) { const f32x4* gt = (const f32x4*)(p.mod_post + (size_t)r * NMODV + (3 * p.ipost + 2) * D) + F.lane; const f32x4* gp = (const f32x4*)p.g_post + F.lane;
#pragma unroll
                for (int j = 0; j < 8; ++j) Ap[j] = gt[64 * j] * gp[64 * j] * p.weight; }
            if (p.has_pre) { const f32x4* scl = (const f32x4*)(p.mod_pre + (size_t)r * NMODV + (3 * p.ipre + 1) * D) + F.lane; const f32x4* sh = (const f32x4*)(p.mod_pre + (size_t)r * NMODV + (3 * p.ipre) * D) + F.lane;
                const f32x4* gq = (const f32x4*)p.g_pre + F.lane;
#pragma unroll
                for (int j = 0; j < 8; ++j) { Aq[j] = gq[64 * j] * (scl[64 * j] + 1.0f); Bq[j] = sh[64 * j]; } }
        }
        const size_t roff = R < MLAT ? (size_t)R * D : (size_t)(R - MLAT) * D;
        const void* xsb = R < MLAT ? p.src_lat : p.src_ctx; void* xdb = R < MLAT ? p.dst_lat : p.dst_ctx;
        f32x4 x[8];
        if (p.src_f32) {
#pragma unroll
            for (int j = 0; j < 8; ++j) x[j] = ((const f32x4*)((const float*)xsb + roff))[F.lane + 64 * j];
        } else {
            f16x4 xh[8];
#pragma unroll
            for (int j = 0; j < 8; ++j) xh[j] = ((const f16x4*)((const _Float16*)xsb + roff))[F.lane + 64 * j];
#pragma unroll
            for (int j = 0; j < 8; ++j) x[j] = __builtin_convertvector(xh[j], f32x4);
        }
        if (p.has_post) {
            u32x2 yw[8];
#pragma unroll
            for (int j = 0; j < 8; ++j) yw[j] = ((const u32x2*)(p.y + (size_t)R * D))[F.lane + 64 * j];
            f32x4 yv[8]; float ss = 0.f;
#pragma unroll
            for (int j = 0; j < 8; ++j) { yv[j] = (f32x4){bflo(yw[j].x), bfhi(yw[j].x), bflo(yw[j].y), bfhi(yw[j].y)};
                ss += (yv[j].x * yv[j].x + yv[j].y * yv[j].y) + (yv[j].z * yv[j].z + yv[j].w * yv[j].w); }
            const float rstd = __builtin_amdgcn_rsqf(wave_sum(ss) * (1.0f / D) + EPS);
#pragma unroll
            for (int j = 0; j < 8; ++j) x[j] = x[j] + Ap[j] * (yv[j] * rstd);
            if (p.dst_f32) {
#pragma unroll
                for (int j = 0; j < 8; ++j) ((f32x4*)((float*)xdb + roff))[F.lane + 64 * j] = x[j];
            } else {
#pragma unroll
                for (int j = 0; j < 8; ++j) { const f16x4 xh = __builtin_convertvector(x[j], f16x4); ((f16x4*)((_Float16*)xdb + roff))[F.lane + 64 * j] = xh; x[j] = __builtin_convertvector(xh, f32x4); }
            }
        }
        if (p.has_pre) {
            float ss = 0.f;
#pragma unroll
            for (int j = 0; j < 8; ++j) ss += (x[j].x * x[j].x + x[j].y * x[j].y) + (x[j].z * x[j].z + x[j].w * x[j].w);
            const float rstd = __builtin_amdgcn_rsqf(wave_sum(ss) * (1.0f / D) + EPS);
            u32x2* ho = (u32x2*)(p.h + (size_t)R * D);
#pragma unroll
            for (int j = 0; j < 8; ++j) { const f32x4 v = (x[j] * rstd) * Aq[j] + Bq[j]; u32x2 w; w.x = pk2(v.x, v.y); w.y = pk2(v.z, v.w); ho[F.lane + 64 * j] = w; }
        }
    }
}

__device__ __forceinline__ f32x4 ld_bf4(const bf16_t* p) { const u32x2 w = *(const u32x2*)p; return (f32x4){bflo(w.x), bfhi(w.x), bflo(w.y), bfhi(w.y)}; }
__device__ __forceinline__ void st_bf4(bf16_t* p, f32x4 v) { u32x2 w; w.x = pk2(v.x, v.y); w.y = pk2(v.z, v.w); *(u32x2*)p = w; }
__device__ __forceinline__ void stencil_phase(ArgsP ap, Frame& F) {
    const bf16_t* P = (const bf16_t*)(ap->ws + WS_HID);
    bf16_t* Y2 = (bf16_t*)(ap->ws + WS_H);
    const int gw = F.vcu * NWAVES + F.wave, NGW = F.G * NWAVES;
    constexpr int SEG = 136, NSEG = MALL / SEG;
    static_assert(NSEG * SEG == MALL, "segment size");
    for (int wu = gw; wu < NSEG * 8; wu += NGW) {
        const int seg = wu >> 3, cb = wu & 7, R0 = seg * SEG;
        if (cb < 4) {
            const int ch = 256 * cb + 4 * F.lane;
            const f32x4 w0 = *(const f32x4*)(ap->in[I_CONVW] + ch), w1 = *(const f32x4*)(ap->in[I_CONVW] + MIXA + ch), w2 = *(const f32x4*)(ap->in[I_CONVW] + 2 * MIXA + ch);
            const f32x4 z = (f32x4){0.f, 0.f, 0.f, 0.f};
            const bf16_t* CV = P + MIXA + ch; const bf16_t* GB = P + ch;
            f32x4 prev = (R0 > 0) ? ld_bf4(CV + (size_t)(R0 - 1) * PCOLS) : z;
            f32x4 cur = ld_bf4(CV + (size_t)R0 * PCOLS);
            for (int Rb = R0; Rb < R0 + SEG; Rb += 8) {
                u32x2 nr[8], gr[8];
#pragma unroll
                for (int i = 0; i < 8; ++i) { const int Rn = (Rb + i + 1 < MALL) ? Rb + i + 1 : MALL - 1;
                    nr[i] = *(const u32x2*)(CV + (size_t)Rn * PCOLS); gr[i] = *(const u32x2*)(GB + (size_t)(Rb + i) * PCOLS); }
#pragma unroll
                for (int i = 0; i < 8; ++i) { const int R = Rb + i;
                    const int slo = R < MLAT ? (R & ~(SEQ - 1)) : MLAT + ((R - MLAT) & ~(CTXL - 1)), shi = slo + (R < MLAT ? SEQ : CTXL);
                    const f32x4 nxt = (R + 1 < MALL) ? (f32x4){bflo(nr[i].x), bfhi(nr[i].x), bflo(nr[i].y), bfhi(nr[i].y)} : z;
                    const f32x4 gb = (f32x4){bflo(gr[i].x), bfhi(gr[i].x), bflo(gr[i].y), bfhi(gr[i].y)};
                    const f32x4 pv = (R - 1 >= slo) ? prev : z, nx = (R + 1 < shi) ? nxt : z;
                    st_bf4(Y2 + (size_t)R * D + ch, gb * (w0 * pv + w1 * cur + w2 * nx));
                    prev = cur; cur = nxt; }
            }
        } else {
            const int gi = cb - 4, half = 1 << gi, ch = 256 * gi + 4 * F.lane;
            const bf16_t* U = P + 2 * MIXA + ch;
            f32x4 S = (f32x4){0.f, 0.f, 0.f, 0.f};
            for (int Rb = R0; Rb < R0 + SEG; Rb += 8) {
                u32x2 ur[8], ar[8], sr[8];
#pragma unroll
                for (int i = 0; i < 8; ++i) { const int R = Rb + i, ra = (R + half < MALL) ? R + half : MALL - 1, rs = (R - half > 0) ? R - half : 0;
                    ur[i] = *(const u32x2*)(U + (size_t)R * PCOLS); ar[i] = *(const u32x2*)(U + (size_t)ra * PCOLS); sr[i] = *(const u32x2*)(U + (size_t)rs * PCOLS); }
#pragma unroll
                for (int i = 0; i < 8; ++i) { const int R = Rb + i;
                    const int plo = R < MLAT ? (R & ~63) : MLAT + ((R - MLAT) & ~(CTXL - 1)), phi = plo + (R < MLAT ? 64 : CTXL);
                    const int lo = (R - half) > plo ? (R - half) : plo, hi = (R + half) < phi ? (R + half) : phi;
                    if (R == R0 || R == plo) {
                        S = (f32x4){0.f, 0.f, 0.f, 0.f};
                        u32x2 rb[16];
#pragma unroll
                        for (int k = 0; k < 16; ++k) rb[k] = *(const u32x2*)(U + (size_t)((lo + k < hi) ? lo + k : lo) * PCOLS);
#pragma unroll
                        for (int k = 0; k < 16; ++k) if (lo + k < hi) S += (f32x4){bflo(rb[k].x), bfhi(rb[k].x), bflo(rb[k].y), bfhi(rb[k].y)};
                    }
                    const float inv = 1.0f / (float)(hi - lo);
                    const f32x4 u = (f32x4){bflo(ur[i].x), bfhi(ur[i].x), bflo(ur[i].y), bfhi(ur[i].y)};
                    st_bf4(Y2 + (size_t)R * D + MIXA + ch, S * inv - u);
                    if (R + half < phi) S += (f32x4){bflo(ar[i].x), bfhi(ar[i].x), bflo(ar[i].y), bfhi(ar[i].y)};
                    if (R - half >= plo) S -= (f32x4){bflo(sr[i].x), bfhi(sr[i].x), bflo(sr[i].y), bfhi(sr[i].y)};
                }
            }
        }
    }
}

__device__ __forceinline__ void s5_disc(float lre, float lim, float dt, float& lbr, float& lbi, float& fr, float& fi) {
    const float mag = expf(lre * dt); float sn, cs; sincosf(lim * dt, &sn, &cs);
    lbr = mag * cs; lbi = mag * sn;
    const float den = lre * lre + lim * lim, nr = lbr - 1.0f;
    fr = (nr * lre + lbi * lim) / den; fi = (lbi * lre - nr * lim) / den;
}
__device__ __forceinline__ int s5_row(int b, int d, int c, int m) { const int isl = c >= 8, L = isl ? SEQ : CTXL, base = isl ? b * SEQ : MLAT + b * CTXL, pos = 32 * (isl ? c - 8 : c) + m; return base + (d ? L - 1 - pos : pos); }
__device__ __forceinline__ void s5_drive_scan(const bf16x8 Uc, const bf16x8 (&Bq)[4], float lbr, float lbi, float& sre, float& sim, unsigned (&pk)[32]) {
    f32x16 acc[4];
#pragma unroll
    for (int q = 0; q < 4; ++q) { acc[q] = (f32x16){0.f, 0.f, 0.f, 0.f, 0.f, 0.f, 0.f, 0.f, 0.f, 0.f, 0.f, 0.f, 0.f, 0.f, 0.f, 0.f};
        acc[q] = __builtin_amdgcn_mfma_f32_32x32x16_bf16(Uc, Bq[q], acc[q], 0, 0, 0); }
    float bre[2][16], bim[2][16];
#pragma unroll
    for (int i = 0; i < 16; ++i) {
        const unsigned x0 = __builtin_bit_cast(unsigned, (float)acc[0][i]), x1 = __builtin_bit_cast(unsigned, (float)acc[1][i]);
        const unsigned y0 = __builtin_bit_cast(unsigned, (float)acc[2][i]), y1 = __builtin_bit_cast(unsigned, (float)acc[3][i]);
        const auto rr = __builtin_amdgcn_permlane32_swap(x0, x1, false, false);
        const auto ri = __builtin_amdgcn_permlane32_swap(y0, y1, false, false);
        bre[0][i] = __builtin_bit_cast(float, (unsigned)rr[0]); bre[1][i] = __builtin_bit_cast(float, (unsigned)rr[1]);
        bim[0][i] = __builtin_bit_cast(float, (unsigned)ri[0]); bim[1][i] = __builtin_bit_cast(float, (unsigned)ri[1]);
    }
    float cr = sre, ci = sim; const float nlbi = -lbi;
#pragma unroll
    for (int blk = 0; blk < 4; ++blk)
#pragma unroll
        for (int hh = 0; hh < 2; ++hh)
#pragma unroll
            for (int i2 = 0; i2 < 4; ++i2) {
                const int i = 4 * blk + i2, t = 8 * blk + 4 * hh + i2;
                float tr, ti, nre, nim;
                asm("v_fma_f32 %0, %1, %2, %3" : "=v"(tr) : "v"(nlbi), "v"(ci), "v"(bre[hh][i]));
                asm("v_fma_f32 %0, %1, %2, %3" : "=v"(ti) : "v"(lbi), "v"(cr), "v"(bim[hh][i]));
                asm("v_fma_f32 %0, %1, %2, %3" : "=v"(nre) : "v"(lbr), "v"(cr), "v"(tr));
                asm("v_fma_f32 %0, %1, %2, %3" : "=v"(nim) : "v"(lbr), "v"(ci), "v"(ti));
                cr = nre; ci = nim; pk[t] = cvt_pk_bf16(nre, nim);
            }
    sre = cr; sim = ci;
}
__device__ __forceinline__ void s5_readout(const LAS unsigned char* img, const bf16x8 (&Cq)[4], bf16_t* YS, int b, int d, int g, int c, int lane) {
#pragma unroll
    for (int tt = 0; tt < 2; ++tt) {
        const int tl = 16 * tt + (lane & 15);
        f32x4 o = (f32x4){0.f, 0.f, 0.f, 0.f};
#pragma unroll
        for (int ks = 0; ks < 4; ++ks) { const bf16x8 Sf = *(const LAS bf16x8*)(img + tl * 256 + (((4 * ks + (lane >> 4)) ^ (tl & 15)) << 4));
            o = __builtin_amdgcn_mfma_f32_16x16x32_bf16(Cq[ks], Sf, o, 0, 0, 0); }
        const int R = s5_row(b, d, c, tl);
        u32x2 w; w.x = cvt_pk_bf16(o[0], o[1]); w.y = cvt_pk_bf16(o[2], o[3]);
        *(u32x2*)(YS + ((size_t)d * MLAT + R) * D + 16 * g + 4 * (lane >> 4)) = w;
    }
}
__device__ __forceinline__ void s5_phase(ArgsP ap, Frame& F) {
    const bf16_t* H = (const bf16_t*)(ap->ws + WS_H);
    bf16_t* YS = (bf16_t*)(ap->ws + WS_HID);
    LAS unsigned char* my = F.lds + F.wave * 16384;
    const int gw = F.vcu * NWAVES + F.wave, NGW = F.G * NWAVES, lane = F.lane;
    for (int wu = gw; wu < BATCH * 2 * 128; wu += NGW) {
        const int g = wu & 127, d = (wu >> 7) & 1, b = wu >> 8, dg = d * 128 + g;
        const float dt = expf(ap->in[I_LSTEP][dg]);
        float lbr2[2], lbi2[2], fr2[2], fi2[2];
#pragma unroll
        for (int hh = 0; hh < 2; ++hh) { const int p = (lane & 31) + 32 * hh; s5_disc(ap->in[I_LRE][dg * 64 + p], ap->in[I_LIM][dg * 64 + p], dt, lbr2[hh], lbi2[hh], fr2[hh], fi2[hh]); }
        const float lbr = lane < 32 ? lbr2[0] : lbr2[1], lbi = lane < 32 ? lbi2[0] : lbi2[1];
        bf16x8 Bq[4];
#pragma unroll
        for (int hh = 0; hh < 2; ++hh) {
            const int p = (lane & 31) + 32 * hh; const float* bre = ap->in[I_BRE] + ((size_t)dg * 64 + p) * 16 + 8 * (lane >> 5); const float* bim = ap->in[I_BIM] + ((size_t)dg * 64 + p) * 16 + 8 * (lane >> 5);
            const f32x4 r0 = *(const f32x4*)bre, r1 = *(const f32x4*)(bre + 4), i0 = *(const f32x4*)bim, i1 = *(const f32x4*)(bim + 4);
            const float frr = fr2[hh], fii = fi2[hh];
            const f32x4 re0 = r0 * frr - i0 * fii, re1 = r1 * frr - i1 * fii, im0 = i0 * frr + r0 * fii, im1 = i1 * frr + r1 * fii;
            u32x4 wre, wim; wre.x = pk2(re0.x, re0.y); wre.y = pk2(re0.z, re0.w); wre.z = pk2(re1.x, re1.y); wre.w = pk2(re1.z, re1.w);
            wim.x = pk2(im0.x, im0.y); wim.y = pk2(im0.z, im0.w); wim.z = pk2(im1.x, im1.y); wim.w = pk2(im1.z, im1.w);
            Bq[hh] = __builtin_bit_cast(bf16x8, wre); Bq[2 + hh] = __builtin_bit_cast(bf16x8, wim);
        }
        bf16x8 Cq[4];
#pragma unroll
        for (int ks = 0; ks < 4; ++ks) { const int p0 = 16 * ks + 4 * (lane >> 4); const size_t off = ((size_t)dg * 16 + (lane & 15)) * 64 + p0;
            const f32x4 cr = *(const f32x4*)(ap->in[I_CRE] + off), ci = *(const f32x4*)(ap->in[I_CIM] + off);
            u32x4 w; w.x = pk2(cr.x, -ci.x); w.y = pk2(cr.y, -ci.y); w.z = pk2(cr.z, -ci.z); w.w = pk2(cr.w, -ci.w); Cq[ks] = __builtin_bit_cast(bf16x8, w); }
        float sre = 0.f, sim = 0.f;
#define row_of(c, m) s5_row(b, d, (c), (m))
        const int hoff = 16 * g + 8 * (lane >> 5);
        LAS unsigned char* ring = F.lds + S5RING_OFF + F.wave * 3072;
#define S5_DMA(c_) __builtin_amdgcn_global_load_lds((const unsigned*)(H + (size_t)row_of((c_), lane & 31) * D + hoff), (LAS unsigned*)(ring + ((c_) % 3) * 1024), 16, 0, 0)
#define S5_UFRAG(c_) (*(const LAS bf16x8*)(ring + ((c_) % 3) * 1024 + lane * 16))
        S5_DMA(0); S5_DMA(1); S5_DMA(2);
        unsigned pk[32];
        for (int c = 0; c < 8; ++c) {
            asm volatile("s_waitcnt vmcnt(2)" ::: "memory");
            const bf16x8 Uc = S5_UFRAG(c);
            s5_drive_scan(Uc, Bq, lbr, lbi, sre, sim, pk);
            S5_DMA(c + 3);
        }
        for (int c = 8; c < 137; ++c) {
            if (c > 8) s5_readout(my + ((c - 1) & 1) * 8192, Cq, YS, b, d, g, c - 1, lane);
            if (c < 136) {
                if (c >= 11 && c < 133) asm volatile("s_waitcnt vmcnt(6)" ::: "memory");
                else if (c < 11) asm volatile("s_waitcnt vmcnt(2)" ::: "memory");
                else asm volatile("s_waitcnt vmcnt(0)" ::: "memory");
                const bf16x8 Uc = S5_UFRAG(c);
                s5_drive_scan(Uc, Bq, lbr, lbi, sre, sim, pk);
                if (c + 3 < 136) S5_DMA(c + 3);
                LAS unsigned char* wb = my + (c & 1) * 8192;
#pragma unroll
                for (int t = 0; t < 32; ++t) *(LAS unsigned*)(wb + t * 256 + ((((lane >> 2) ^ (t & 15))) << 4) + (lane & 3) * 4) = pk[t];
            }
            asm volatile("s_waitcnt lgkmcnt(0)" ::: "memory");
        }
#undef S5_DMA
#undef S5_UFRAG
    }
}

#undef row_of
__device__ __forceinline__ float gelu_tanh(float x) { const float z = 0.7978845608028654f * (x + 0.044715f * x * x * x); return x * fast_sigmoid(2.0f * z); }
__device__ __forceinline__ void combine_phase(ArgsP ap, Frame& F) {
    bf16_t* H = (bf16_t*)(ap->ws + WS_H); const bf16_t* YS = (const bf16_t*)(ap->ws + WS_HID); const float* dv = ap->in[I_S5D];
    const size_t nvec = (size_t)MLAT * D / 8, stride = (size_t)F.G * NWAVES * 64;
    for (size_t i = (size_t)blockIdx.x * (NWAVES * 64) + F.tid; i < nvec; i += stride) {
        const int c0 = (int)((i * 8) & (D - 1));
        const u32x4 hw = *(const u32x4*)(H + i * 8), y0 = *(const u32x4*)(YS + i * 8), y1 = *(const u32x4*)(YS + (size_t)MLAT * D + i * 8);
        const f32x4 d0 = *(const f32x4*)(dv + c0), d1 = *(const f32x4*)(dv + c0 + 4);
        float v[8];
        v[0] = bflo(hw.x) * d0.x + bflo(y0.x) + bflo(y1.x); v[1] = bfhi(hw.x) * d0.y + bfhi(y0.x) + bfhi(y1.x);
        v[2] = bflo(hw.y) * d0.z + bflo(y0.y) + bflo(y1.y); v[3] = bfhi(hw.y) * d0.w + bfhi(y0.y) + bfhi(y1.y);
        v[4] = bflo(hw.z) * d1.x + bflo(y0.z) + bflo(y1.z); v[5] = bfhi(hw.z) * d1.y + bfhi(y0.z) + bfhi(y1.z);
        v[6] = bflo(hw.w) * d1.z + bflo(y0.w) + bflo(y1.w); v[7] = bfhi(hw.w) * d1.w + bfhi(y0.w) + bfhi(y1.w);
#pragma unroll
        for (int j = 0; j < 8; ++j) v[j] = gelu_tanh(v[j]);
        u32x4 o; o.x = pk2(v[0], v[1]); o.y = pk2(v[2], v[3]); o.z = pk2(v[4], v[5]); o.w = pk2(v[6], v[7]);
        *(u32x4*)(H + i * 8) = o;
    }
}

constexpr int N_PHASES = 22;
__device__ __forceinline__ Frame make_frame(LAS unsigned char* lds, int tid) {
    Frame F; F.lds = lds; F.tid = tid; F.lane = tid & 63; F.wave = __builtin_amdgcn_readfirstlane(tid >> 6);
    F.G = gridDim.x; { const int bx = blockIdx.x; F.vcu = (F.G % 8 == 0) ? (bx % 8) * (F.G / 8) + bx / 8 : bx; }
    return F;
}
__global__ void __launch_bounds__(NWAVES * 64, 2) fwd_kernel(Args args_unused) {
    extern __shared__ __attribute__((aligned(16))) unsigned char lds[];
    LAS unsigned char* const L = (LAS unsigned char*)lds;
    unsigned long long kp = (unsigned long long)__builtin_amdgcn_kernarg_segment_ptr();
    int tid0 = threadIdx.x;
    volatile LAS unsigned* MISC = (volatile LAS unsigned*)(L + MISC_OFF);
    for (int u = tid0; u < (LDS_BYTES - LDSCTL_OFF) / 4; u += NWAVES * 64) ((LAS unsigned*)(L + LDSCTL_OFF))[u] = 0u;
    __syncthreads();
    const int lo = ((ArgsP)kp)->ph_lo, hi = ((ArgsP)kp)->ph_hi;
    XcdBarrier bar; bar.bar = (unsigned*)(((ArgsP)kp)->ws + WS_CTL) + CW_BAR; bar.x = 0; bar.st = nullptr;
    if (hi - lo > 1) bar = xcd_barrier_post(bar.bar, MISC + 8);
    int ph = 0;
#define PH_ON (ph >= lo && ph < hi)
#define PH_BEGIN asm volatile("" : "+s"(kp)); int tid = tid0; asm volatile("" : "+v"(tid)); const ArgsP ap = (ArgsP)kp; Frame F = make_frame(L, tid); unsigned char* const ws = ap->ws; (void)ws; (void)F;
#define PH_END do { if (ph >= lo && ph + 1 < hi) xcd_barrier(bar); ++ph; } while (0)
#define WSP(T, off) ((T*)(ws + (off)))

    if (PH_ON) { PH_BEGIN; p0_prologue(ap, F); }
    PH_END;

    for (int s = 0; s < 4; ++s) {
        const int l = s >> 1, Ms = (s == 3) ? MLAT : MALL;
        if (PH_ON) {
            PH_BEGIN;
            const float* MOD = WSP(const float, WS_MOD); const float* NG = ap->in[I_NORMG]; void* X = WSP(void, WS_X16); void* XC = WSP(void, WS_XC);
            NormP p{};
            p.y = WSP(const bf16_t, WS_Y); p.h = WSP(bf16_t, WS_H); p.M = Ms; p.has_pre = 1;
            p.mod_pre = MOD + (size_t)l * 9 * NMODV; p.ipre = (s & 1) ? 2 : 0; p.g_pre = NG + (size_t)(l * 6 + 2 * p.ipre) * D;
            if (s == 0) { p.has_post = 0; p.src_lat = ap->in[I_X]; p.src_ctx = ap->in[I_CTX]; p.src_f32 = 1; p.dst_lat = X; p.dst_ctx = XC; p.mod_post = MOD; p.g_post = NG; p.ipost = 0; p.weight = 0.f; }
            else { const int lp = (s == 2) ? 0 : l, ip = (s == 2) ? 2 : 1;
                p.has_post = 1; p.src_lat = X; p.src_ctx = XC; p.dst_lat = X; p.dst_ctx = XC; p.mod_post = MOD + (size_t)lp * 9 * NMODV; p.ipost = ip; p.g_post = NG + (size_t)(lp * 6 + 2 * ip + 1) * D; p.weight = (ip == 1) ? 1.0f : 0.5f; }
            norm_phase(F, p);
        }
        PH_END;
        if (PH_ON) {
            PH_BEGIN;
            pg8::Gemm g{WSP(const bf16_t, WS_H), WSP(const bf16_t, WS_WGU) + (size_t)s * (2 * DFF) * D, Ms, 2 * DFF, D, D, D, 0};
            pg8::StaticOrder S; S.init(Ms, 2 * DFF, F.G, (int)blockIdx.x);
            pg8::EpiGated<0> E{WSP(bf16_t, WS_HID), DFF};
            pg8::gemm_phase<pg8::EpiGated<0>, pg8::StaticOrder, true, true>(L, g, S, E, tid);
        }
        PH_END;
        if (PH_ON) {
            PH_BEGIN;
            pg8::Gemm g{WSP(const bf16_t, WS_HID), WSP(const bf16_t, WS_WD) + (size_t)s * D * DFF, Ms, D, DFF, DFF, DFF, 0};
            pg8::StaticOrder S; S.init(Ms, D, F.G, (int)blockIdx.x, 4, 1, 1);
            pg8::EpiBf16 E{WSP(bf16_t, WS_Y), D, nullptr};
            pg8::gemm_phase<pg8::EpiBf16, pg8::StaticOrder, false, true>(L, g, S, E, tid);
            if (s < 3) {
                const int nu = (MALL / 256) * (D / 256), fi = nu % F.G;
                __syncthreads();
                if (s == 0) convert_in_tail(ap, F, fi, 3 * CV_FFN, 6 * CV_FFN, CV_MIX0, CV_MIX1);
                else if (s == 1) convert_in_tail(ap, F, fi, 6 * CV_FFN, 9 * CV_FFN, 0, 0);
                else convert_in_tail(ap, F, fi, 9 * CV_FFN, 12 * CV_FFN, CV_MIX1, CV_GLU1);
            }
        }
        PH_END;
        if (s == 0 || s == 2) {
            if (PH_ON) {
                PH_BEGIN;
                const float* MOD = WSP(const float, WS_MOD); const float* NG = ap->in[I_NORMG]; void* X = WSP(void, WS_X16); void* XC = WSP(void, WS_XC);
                NormP p{};
                p.y = WSP(const bf16_t, WS_Y); p.h = WSP(bf16_t, WS_H); p.M = MALL; p.has_pre = 1; p.has_post = 1;
                p.src_lat = (s == 0) ? (const void*)ap->in[I_X] : (const void*)X; p.src_ctx = (s == 0) ? (const void*)ap->in[I_CTX] : (const void*)XC; p.src_f32 = (s == 0); p.dst_lat = X; p.dst_ctx = XC;
                p.mod_post = MOD + (size_t)l * 9 * NMODV; p.ipost = 0; p.g_post = NG + (size_t)(l * 6 + 1) * D; p.weight = 0.5f;
                p.mod_pre = MOD + (size_t)l * 9 * NMODV; p.ipre = 1; p.g_pre = NG + (size_t)(l * 6 + 2) * D;
                norm_phase(F, p);
            }
            PH_END;
        }
        if (s == 0) {
            if (PH_ON) {
                PH_BEGIN;
                pg8::Gemm g{WSP(const bf16_t, WS_H), WSP(const bf16_t, WS_WIN), MALL, INCOLS, D, D, D, 0};
                pg8::StaticOrder S; S.init(MALL, INCOLS, F.G, (int)blockIdx.x);
                pg8::EpiInProj E{WSP(bf16_t, WS_HID), PCOLS};
                pg8::gemm_phase<pg8::EpiInProj, pg8::StaticOrder, true, true>(L, g, S, E, tid);
            }
            if (PH_ON) {
                PH_BEGIN;
                const int nui = (MALL / 256) * (INCOLS / 256), fii = nui % F.G;
                if ((int)blockIdx.x >= fii) {
                    pg8::Gemm g{WSP(const bf16_t, WS_TMP) + MIXA, WSP(const bf16_t, WS_PWT), D, 1024, 256, D, 256, 256};
                    pg8::StaticOrder S; S.init(D, 1024, F.G - fii, (int)blockIdx.x - fii);
                    pg8::EpiBf16 E{WSP(bf16_t, WS_WOUT) + MIXA, D, nullptr};
                    pg8::gemm_phase<pg8::EpiBf16, pg8::StaticOrder, true, true>(L, g, S, E, tid);
                }
            }
            PH_END;
            if (PH_ON) { PH_BEGIN; stencil_phase(ap, F); }
            PH_END;
            if (PH_ON) {
                PH_BEGIN;
                pg8::Gemm g{WSP(const bf16_t, WS_H), WSP(const bf16_t, WS_WOUT), MALL, D, D, D, D, 0};
                pg8::StaticOrder S; S.init(MALL, D, F.G, (int)blockIdx.x, 4, 0, 1);
                pg8::EpiBf16 E{WSP(bf16_t, WS_Y), D, nullptr};
                pg8::gemm_phase<pg8::EpiBf16, pg8::StaticOrder, true, true>(L, g, S, E, tid);
            }
            PH_END;
        }
        if (s == 2) {
            if (PH_ON) { PH_BEGIN; s5_phase(ap, F); }
            PH_END;
            if (PH_ON) { PH_BEGIN; combine_phase(ap, F); }
            PH_END;
            if (PH_ON) {
                PH_BEGIN;
                pg8::Gemm g{WSP(const bf16_t, WS_H), WSP(const bf16_t, WS_WAB), MLAT, 2 * D, D, D, D, 0};
                pg8::StaticOrder S; S.init(MLAT, 2 * D, F.G, (int)blockIdx.x);
                pg8::EpiGated<1> E{WSP(bf16_t, WS_Y), D};
                pg8::gemm_phase<pg8::EpiGated<1>, pg8::StaticOrder, true, true>(L, g, S, E, tid);
            }
            PH_END;
        }
    }
    if (PH_ON) {
        PH_BEGIN;
        const float* MOD = WSP(const float, WS_MOD); const float* NG = ap->in[I_NORMG]; void* X = WSP(void, WS_X16); void* XC = WSP(void, WS_XC);
        NormP p{};
        p.y = WSP(const bf16_t, WS_Y); p.h = WSP(bf16_t, WS_H); p.M = MLAT; p.has_pre = 0; p.has_post = 1;
        p.src_lat = X; p.src_ctx = XC; p.dst_lat = ap->out; p.dst_ctx = XC; p.dst_f32 = 1;
        p.mod_post = MOD + (size_t)9 * NMODV; p.ipost = 2; p.g_post = NG + (size_t)(6 + 5) * D; p.weight = 0.5f;
        p.mod_pre = MOD; p.ipre = 0; p.g_pre = NG;
        norm_phase(F, p);
    }
    PH_END;
#undef PH_ON
#undef PH_BEGIN
#undef PH_END
#undef WSP
}

extern "C" void kernel_launch(void* const* d_in, const int* in_sizes, int n_in, void* d_out, int out_size, void* d_ws, size_t ws_size, hipStream_t stream) {
    static int grid = 0;
    if (grid == 0) {
        if (n_in != N_IN || in_sizes[0] != MLAT * D || out_size != MLAT * D || ws_size < WS_END) {
            fprintf(stderr, "kernel_launch: unexpected shapes (n_in %d, in0 %d, out %d, ws %zu); nothing launched\n", n_in, n_in > 0 ? in_sizes[0] : -1, out_size, ws_size); grid = -1; return; }
        int dev = 0, cus = 0, per_cu = 0;
        if (hipGetDevice(&dev) != hipSuccess || hipDeviceGetAttribute(&cus, hipDeviceAttributeMultiprocessorCount, dev) != hipSuccess) { fprintf(stderr, "kernel_launch: device query failed\n"); grid = -1; return; }
        if (hipFuncSetAttribute((const void*)fwd_kernel, hipFuncAttributeMaxDynamicSharedMemorySize, LDS_BYTES) != hipSuccess) { fprintf(stderr, "kernel_launch: hipFuncSetAttribute failed\n"); grid = -1; return; }
        if (hipOccupancyMaxActiveBlocksPerMultiprocessor(&per_cu, (const void*)fwd_kernel, NWAVES * 64, LDS_BYTES) != hipSuccess || per_cu < 1) {
            fprintf(stderr, "kernel_launch: occupancy query reports %d workgroups per CU; nothing launched\n", per_cu); (void)hipGetLastError(); grid = -1; return; }
        grid = cus;
    }
    if (grid < 0) return;
    if (hipMemsetAsync((char*)d_ws + WS_CTL, 0, CTL_ZERO_BYTES, stream) != hipSuccess) { fprintf(stderr, "kernel_launch: memset failed\n"); return; }
    Args a{};
    for (int i = 0; i < N_IN; ++i) a.in[i] = (const float*)d_in[i];
    a.out = (float*)d_out; a.ws = (unsigned char*)d_ws; a.li = 0; a.pad = 0;
#if MK_PER_PHASE
    for (int k = 0; k < N_PHASES; ++k) { a.ph_lo = k; a.ph_hi = k + 1; hipLaunchKernelGGL(fwd_kernel, dim3(grid), dim3(NWAVES * 64), LDS_BYTES, stream, a); }
#else
    a.ph_lo = 0; a.ph_hi = N_PHASES;
    hipLaunchKernelGGL(fwd_kernel, dim3(grid), dim3(NWAVES * 64), LDS_BYTES, stream, a);
#endif
    const hipError_t le = hipPeekAtLastError();
    if (le != hipSuccess) fprintf(stderr, "kernel_launch: launch failed: %s\n", hipGetErrorName(le));
}
```
